# Optimizing an MI355X kernel written in HIP

```python
import math
import jax, jax.numpy as jnp
from jax import lax
import numpy as np

D_MODEL = 2048
BATCH = 4
SEQ = 8192
DEPTH = 1

CHUNK = 64
Q_BLOCK = 128

MLA_HEADS = 8
MLA_Q_LORA = 512
MLA_KV_LORA = 256
MLA_NOPE = 128
MLA_ROPE = 64
MLA_V = 128
ROPE_THETA = 10000.0

FOX_HEADS = 8
FOX_HEAD_DIM = 128

D_FF = 4 * D_MODEL

EPS = 1e-6

OFF_CQ = 0
OFF_CKV = OFF_CQ + MLA_Q_LORA
OFF_KR = OFF_CKV + MLA_KV_LORA
OFF_FQ = OFF_KR + MLA_ROPE
OFF_FK = OFF_FQ + FOX_HEADS * FOX_HEAD_DIM
OFF_FV = OFF_FK + FOX_HEADS * FOX_HEAD_DIM
OFF_FF = OFF_FV + FOX_HEADS * FOX_HEAD_DIM
OFF_G = OFF_FF + FOX_HEADS
D_IN = OFF_G + 2 * D_MODEL

kernel_name = "hybrid_mla_fox_gated_block"


def rmsnorm(x, g):
    xf = x.astype(jnp.float32)
    y = xf * lax.rsqrt(jnp.mean(xf * xf, axis=-1, keepdims=True) + EPS)
    return (y * g.astype(jnp.float32)).astype(x.dtype)


def rope_tables(seq_len):
    pos = jnp.arange(seq_len, dtype=jnp.float32)
    inv = 1.0 / (ROPE_THETA ** (jnp.arange(0, MLA_ROPE, 2, dtype=jnp.float32) / MLA_ROPE))
    ang = pos[:, None] * inv[None, :]
    return jnp.cos(ang), jnp.sin(ang)


def apply_rope(x, cos, sin):
    half = x.shape[-1] // 2
    x1, x2 = x[..., :half], x[..., half:]
    c = cos.astype(x.dtype)
    s = sin.astype(x.dtype)
    return jnp.concatenate([x1 * c - x2 * s, x1 * s + x2 * c], axis=-1)


def block_attention(q, k, v, scale, chunk_causal, cum=None):
    B, H, S, Dq = q.shape
    Dv = v.shape[-1]
    nb = S // Q_BLOCK
    qb = q.reshape(B, H, nb, Q_BLOCK, Dq).transpose(2, 0, 1, 3, 4)
    k_pos = jnp.arange(S)
    xs = (jnp.arange(nb), qb)
    if cum is not None:
        cb = cum.reshape(B, H, nb, Q_BLOCK).transpose(2, 0, 1, 3)
        xs = xs + (cb,)

    def one_block(args):
        i, q_blk = args[0], args[1]
        s = jnp.einsum('bhqd,bhkd->bhqk', q_blk, k,
                       preferred_element_type=jnp.float32) * scale
        q_pos = i * Q_BLOCK + jnp.arange(Q_BLOCK)
        if chunk_causal:
            mask = (k_pos // CHUNK)[None, :] <= (q_pos // CHUNK)[:, None]
        else:
            mask = k_pos[None, :] <= q_pos[:, None]
        if cum is not None:
            c_blk = args[2]
            s = s + c_blk[..., :, None] - cum[:, :, None, :]
        s = jnp.where(mask, s, -jnp.inf)
        p = jax.nn.softmax(s, axis=-1)
        return jnp.einsum('bhqk,bhkd->bhqd', p.astype(v.dtype), v)

    out = lax.map(one_block, xs)
    return out.transpose(1, 2, 0, 3, 4).reshape(B, H, S, Dv)


def mla_branch(proj, q_norm, w_uq, kv_norm, w_ukv, cos, sin):
    B, S, _ = proj.shape
    cq = rmsnorm(proj[..., OFF_CQ:OFF_CKV], q_norm)
    q = (cq @ w_uq).reshape(B, S, MLA_HEADS, MLA_NOPE + MLA_ROPE).transpose(0, 2, 1, 3)
    ckv = rmsnorm(proj[..., OFF_CKV:OFF_KR], kv_norm)
    kv = (ckv @ w_ukv).reshape(B, S, MLA_HEADS, MLA_NOPE + MLA_V).transpose(0, 2, 1, 3)
    k_nope, v = kv[..., :MLA_NOPE], kv[..., MLA_NOPE:]
    k_rope = apply_rope(proj[:, None, :, OFF_KR:OFF_FQ], cos, sin)
    q = jnp.concatenate([q[..., :MLA_NOPE], apply_rope(q[..., MLA_NOPE:], cos, sin)], axis=-1)
    k = jnp.concatenate(
        [k_nope, jnp.broadcast_to(k_rope, (B, MLA_HEADS, S, MLA_ROPE))], axis=-1)
    o = block_attention(q, k, v, 1.0 / math.sqrt(MLA_NOPE + MLA_ROPE), chunk_causal=True)
    return o.transpose(0, 2, 1, 3).reshape(B, S, MLA_HEADS * MLA_V)


def fox_branch(proj, f_bias):
    B, S, _ = proj.shape

    def heads(a):
        return a.reshape(B, S, FOX_HEADS, FOX_HEAD_DIM).transpose(0, 2, 1, 3)

    q = heads(proj[..., OFF_FQ:OFF_FK])
    k = heads(proj[..., OFF_FK:OFF_FV])
    v = heads(proj[..., OFF_FV:OFF_FF])
    logf = jax.nn.log_sigmoid((proj[..., OFF_FF:OFF_G] + f_bias).astype(jnp.float32))
    cum = jnp.cumsum(logf, axis=1).transpose(0, 2, 1)
    o = block_attention(q, k, v, 1.0 / math.sqrt(FOX_HEAD_DIM), chunk_causal=False, cum=cum)
    return o.transpose(0, 2, 1, 3).reshape(B, S, FOX_HEADS * FOX_HEAD_DIM)


def setup_inputs(seed: int = 0) -> dict:
    key = jax.random.key(seed)
    ks = jax.random.split(key, 20)
    f32 = jnp.float32

    def w(k, shape, fan_in):
        return jax.random.normal(k, shape, f32) * (fan_in ** -0.5)

    def gain(k, shape):
        return 1.0 + 0.02 * jax.random.normal(k, shape, f32)

    return {
        "x": jax.random.normal(ks[0], (BATCH, SEQ, D_MODEL), f32),
        "attn_norm": gain(ks[1], (DEPTH, D_MODEL)),
        "w_in": w(ks[2], (DEPTH, D_MODEL, D_IN), D_MODEL),
        "fox_f_bias": jax.random.uniform(ks[3], (DEPTH, FOX_HEADS), f32, 1.0, 6.0),
        "q_norm": gain(ks[4], (DEPTH, MLA_Q_LORA)),
        "w_uq": w(ks[5], (DEPTH, MLA_Q_LORA, MLA_HEADS * (MLA_NOPE + MLA_ROPE)), MLA_Q_LORA),
        "kv_norm": gain(ks[6], (DEPTH, MLA_KV_LORA)),
        "w_ukv": w(ks[7], (DEPTH, MLA_KV_LORA, MLA_HEADS * (MLA_NOPE + MLA_V)), MLA_KV_LORA),
        "w_mla_branch": w(ks[8], (DEPTH, MLA_HEADS * MLA_V, D_MODEL), MLA_HEADS * MLA_V),
        "w_fox_branch": w(ks[9], (DEPTH, FOX_HEADS * FOX_HEAD_DIM, D_MODEL), FOX_HEADS * FOX_HEAD_DIM),
        "w_out": w(ks[10], (DEPTH, D_MODEL, D_MODEL), D_MODEL),
        "mlp_norm": gain(ks[11], (DEPTH, D_MODEL)),
        "w_up": w(ks[12], (DEPTH, D_MODEL, D_FF), D_MODEL),
        "w_down": w(ks[13], (DEPTH, D_FF, D_MODEL), D_FF),
        "final_norm": gain(ks[14], (D_MODEL,)),
    }


def reference(x, attn_norm, w_in, fox_f_bias, q_norm, w_uq, kv_norm, w_ukv,
              w_mla_branch, w_fox_branch, w_out, mlp_norm, w_up, w_down, final_norm):
    S = x.shape[1]
    cos, sin = rope_tables(S)
    h = x
    for l in range(DEPTH):
        xn = rmsnorm(h, attn_norm[l])
        proj = xn @ w_in[l]
        y_mla = mla_branch(proj, q_norm[l], w_uq[l], kv_norm[l], w_ukv[l], cos, sin) @ w_mla_branch[l]
        y_fox = fox_branch(proj, fox_f_bias[l]) @ w_fox_branch[l]
        gates = jax.nn.sigmoid(proj[..., OFF_G:])
        g_mla, g_fox = gates[..., :D_MODEL], gates[..., D_MODEL:]
        h = h + (g_mla * y_mla + g_fox * y_fox) @ w_out[l]
        hn = rmsnorm(h, mlp_norm[l])
        u = jnp.square(jax.nn.relu(hn @ w_up[l]))
        h = h + u @ w_down[l]
    return rmsnorm(h, final_norm)
```

```cpp
#include <hip/hip_runtime.h>
#include <hip/hip_bf16.h>
#include <hip/hip_cooperative_groups.h>
#include <cstdio>
#include <cstdint>
namespace cg = cooperative_groups;

#ifndef MK_MULTI
#define MK_MULTI 0
#endif

#ifndef OWN_GEMM
#define OWN_GEMM 1
#endif
#ifndef OWN_ATT
#define OWN_ATT 1
#endif
#ifndef OWN_ROWS
#define OWN_ROWS 1
#endif
constexpr int BATCH = 4, SEQ = 8192, DMODEL = 2048, MROWS = BATCH * SEQ, DIN = 8008, NPROJ = 8192, DFF = 8192;
constexpr float EPS = 1e-6f;
enum { EM_PROJ = 0, EM_QUP, EM_KVUP, EM_BR1, EM_BR2, EM_OUT, EM_UP, EM_DOWN };
namespace pg8 {
#define PG8_LAS __attribute__((address_space(3)))
typedef unsigned short bf16_t;
typedef short bf16x8 __attribute__((ext_vector_type(8)));
typedef float f32x4 __attribute__((ext_vector_type(4)));
typedef unsigned u32x4 __attribute__((ext_vector_type(4)));
constexpr int BM = 256, BK = 64, HALF = 128, HTB = HALF * BK * 2  , STAGE_BYTES = 8 * HTB, NXCD = 8, WGM = 8;

__host__ __device__ __forceinline__ int lds_byte(int r, int c) { const int st = (r >> 4) * 2 + (c >> 5), rr = r & 15, cc = c & 31, ob = rr * 64 + cc * 2; return st * 1024 + (ob ^ (((ob >> 9) & 1) << 5)); }
__host__ __device__ __forceinline__ void stage_rc(int b, int& R, int& C) { const int st = b / 1024, sb = b % 1024, swz = sb ^ (((sb >> 9) & 1) << 5); R = (st >> 1) * 16 + swz / 64; C = (st & 1) * 32 + (swz % 64) / 2; }
__host__ __device__ __forceinline__ int perm32(int rho) { const int n = rho >> 4, i = rho & 15; return 8 * (i >> 2) + 4 * n + (i & 3); }

struct Unit { int pm, pn; };
struct Gemm { const bf16_t* A; const bf16_t* Bt; int M, N, K; };

struct StaticOrder {
    int nM, nN, nwg, G, c;
    __host__ __device__ void init(int M, int N, int G_, int c_) { nM = M / BM; nN = N / BM; nwg = nM * nN; G = G_; c = c_; }
    __host__ __device__ bool next(int i, Unit& u) const {
        const long L = (long)i * G + c; if (L >= nwg) return false;
        int wgid = (int)L; { const int q = nwg / NXCD, r = nwg % NXCD, xcd = wgid % NXCD, off = wgid / NXCD; wgid = (xcd < r ? xcd * (q + 1) : r * (q + 1) + (xcd - r) * q) + off; }
        const int nig = WGM * nN, gid = wgid / nig, fm = gid * WGM, gsz = (nM - fm) < WGM ? (nM - fm) : WGM;
        u.pm = fm + ((wgid % nig) % gsz); u.pn = (wgid % nig) / gsz; return true;
    }
    __device__ __forceinline__ void a_ready(const Unit&) const {}
    __device__ __forceinline__ void done(const Unit&) const {}
};

typedef float f32x2c_t __attribute__((ext_vector_type(2))); typedef __bf16 bf16x2c_t __attribute__((ext_vector_type(2)));
__device__ __forceinline__ unsigned cvt_pk_bf16(float lo, float hi) { f32x2c_t v = {lo, hi}; bf16x2c_t b = __builtin_convertvector(v, bf16x2c_t); return __builtin_bit_cast(unsigned, b); }
typedef float f32x2 __attribute__((ext_vector_type(2)));
typedef unsigned u32x2 __attribute__((ext_vector_type(2)));
__device__ __forceinline__ u32x4 pack8(f32x4 a, f32x4 b) { u32x4 w; w.x = cvt_pk_bf16(a[0], a[1]); w.y = cvt_pk_bf16(a[2], a[3]); w.z = cvt_pk_bf16(b[0], b[1]); w.w = cvt_pk_bf16(b[2], b[3]); return w; }
__device__ __forceinline__ void unpack8(u32x4 w, f32x4& a, f32x4& b) {
    a[0] = __uint_as_float(w.x << 16); a[1] = __uint_as_float(w.x & 0xffff0000u); a[2] = __uint_as_float(w.y << 16); a[3] = __uint_as_float(w.y & 0xffff0000u);
    b[0] = __uint_as_float(w.z << 16); b[1] = __uint_as_float(w.z & 0xffff0000u); b[2] = __uint_as_float(w.w << 16); b[3] = __uint_as_float(w.w & 0xffff0000u); }
__device__ __forceinline__ void rope8(f32x4& a, f32x4& b, const float* tab) {
    const f32x4 t0 = *(const f32x4*)tab, t1 = *(const f32x4*)(tab + 4);
    float x1, x2;
    x1 = a[0]; x2 = a[1]; a[0] = x1 * t0[0] - x2 * t0[1]; a[1] = x1 * t0[1] + x2 * t0[0];
    x1 = a[2]; x2 = a[3]; a[2] = x1 * t0[2] - x2 * t0[3]; a[3] = x1 * t0[3] + x2 * t0[2];
    x1 = b[0]; x2 = b[1]; b[0] = x1 * t1[0] - x2 * t1[1]; b[1] = x1 * t1[1] + x2 * t1[0];
    x1 = b[2]; x2 = b[3]; b[2] = x1 * t1[2] - x2 * t1[3]; b[3] = x1 * t1[3] + x2 * t1[2];
}
__device__ __forceinline__ void rope8v(f32x4& a, f32x4& b, const f32x4 t0, const f32x4 t1) {
    float x1, x2;
    x1 = a[0]; x2 = a[1]; a[0] = x1 * t0[0] - x2 * t0[1]; a[1] = x1 * t0[1] + x2 * t0[0];
    x1 = a[2]; x2 = a[3]; a[2] = x1 * t0[2] - x2 * t0[3]; a[3] = x1 * t0[3] + x2 * t0[2];
    x1 = b[0]; x2 = b[1]; b[0] = x1 * t1[0] - x2 * t1[1]; b[1] = x1 * t1[1] + x2 * t1[0];
    x1 = b[2]; x2 = b[3]; b[2] = x1 * t1[2] - x2 * t1[3]; b[3] = x1 * t1[3] + x2 * t1[2];
}
__device__ __forceinline__ float sigm(float v) { return __builtin_amdgcn_rcpf(1.f + __expf(-v)); }
__device__ __forceinline__ float sumsq8(f32x4 a, f32x4 b) { return (a[0] * a[0] + a[1] * a[1]) + (a[2] * a[2] + a[3] * a[3]) + (b[0] * b[0] + b[1] * b[1]) + (b[2] * b[2] + b[3] * b[3]); }
__device__ __forceinline__ void ssq_commit(float* p, float s, int fq) { s += __shfl_xor(s, 16); s += __shfl_xor(s, 32); if (fq == 0) *p = s; }
template <int NS> __device__ __forceinline__ float ssq_sum(const float* p) { float s = 0.f;
#pragma unroll
    for (int i = 0; i < NS / 4; ++i) { const f32x4 v = *(const f32x4*)(p + 4 * i); s += (v[0] + v[1]) + (v[2] + v[3]); } return s; }

template <int NS> __device__ __forceinline__ float ssq_sum_sh(const float* p, int fq) {
    float s;
    if (NS == 32) { const f32x4 a = *(const f32x4*)(p + 8 * fq), b = *(const f32x4*)(p + 8 * fq + 4); s = ((a[0] + a[1]) + (a[2] + a[3])) + ((b[0] + b[1]) + (b[2] + b[3])); }
    else if (NS == 8) { s = p[2 * fq] + p[2 * fq + 1]; }
    else { s = p[fq]; }
    s += __shfl_xor(s, 16); s += __shfl_xor(s, 32); return s;
}
struct Epi {
    static constexpr bool PERM = true, AFTER_DRAIN = false;
    int mode;
    bf16_t *CQ, *CKV, *KR, *FQKV, *GATES, *QM, *KN, *VM, *MIX, *TMP, *H1B, *U;
    float *FF, *SQ, *SKV, *SH1, *SH2, *OUT; const float* X; const float* ROPE; const float* GN; unsigned* PCNT; int fuse8;
    __device__ __forceinline__ void operator()(f32x4 (&acc)[2][2][4][2], const Unit& u, int wr, int wc, int fr, int fq) const {
        const int rowb = u.pm * BM + wr * 64 + fr, colb = u.pn * BM + wc * 32 + 8 * fq;
        constexpr size_t MR = (size_t)MROWS; (void)MR;
#define ROWOF(ai, m) ((size_t)(rowb + (ai) * HALF + (m) * 16))
        if (mode == EM_PROJ) {
            const int pn = u.pn;
#pragma unroll
            for (int ai = 0; ai < 2; ++ai)
#pragma unroll
                for (int m = 0; m < 4; ++m) { const size_t rw = ROWOF(ai, m); const int row = (int)rw;
                    if (pn < 3) { float ss = 0.f;
#pragma unroll
                        for (int bj = 0; bj < 2; ++bj) { const int col = colb + bj * HALF; const f32x4 v0 = acc[ai][bj][m][0], v1 = acc[ai][bj][m][1]; ss += sumsq8(v0, v1);
                            if (pn < 2) *(u32x4*)(CQ + rw * 512 + col) = pack8(v0, v1); else *(u32x4*)(CKV + rw * 256 + (col - 512)) = pack8(v0, v1); }
                        if (pn < 2) ssq_commit(SQ + rw * 8 + pn * 4 + wc, ss, fq); else ssq_commit(SKV + rw * 4 + wc, ss, fq);
                    } else if (pn == 3) {
                        const int lc = wc * 32 + 8 * fq;
                        if (lc < 64) { if (m == 0) {
                                f32x4 tb[4][2];
#pragma unroll
                                for (int mm = 0; mm < 4; ++mm) { const float* tp = ROPE + ((ROWOF(ai, mm) & (size_t)(SEQ - 1)) * 32 + (size_t)(lc >> 1)) * 2; tb[mm][0] = *(const f32x4*)tp; tb[mm][1] = *(const f32x4*)(tp + 4); }
#pragma unroll
                                for (int mm = 0; mm < 4; ++mm) { f32x4 v0 = acc[ai][0][mm][0], v1 = acc[ai][0][mm][1]; rope8v(v0, v1, tb[mm][0], tb[mm][1]); *(u32x4*)(KR + ROWOF(ai, mm) * 64 + lc) = pack8(v0, v1); } } }
                        else if (lc == 64) { *(f32x4*)(FF + rw * 8) = acc[ai][0][m][0]; *(f32x4*)(FF + rw * 8 + 4) = acc[ai][0][m][1]; }
                    } else if (pn < 16) {
                        const int t = (pn - 4) >> 2;
#pragma unroll
                        for (int bj = 0; bj < 2; ++bj) { const int col = colb + bj * HALF - 1024 - t * 1024; *(u32x4*)(FQKV + (size_t)t * MR * 1024 + rw * 1024 + col) = pack8(acc[ai][bj][m][0], acc[ai][bj][m][1]); }
                    } else {
#pragma unroll
                        for (int bj = 0; bj < 2; ++bj) { const int col = colb + bj * HALF - 4096; f32x4 v0 = acc[ai][bj][m][0], v1 = acc[ai][bj][m][1];
#pragma unroll
                            for (int i = 0; i < 4; ++i) { v0[i] = sigm(v0[i]); v1[i] = sigm(v1[i]); }
                            *(u32x4*)(GATES + rw * 4096 + col) = pack8(v0, v1); }
                    }
                }
        } else if (mode == EM_QUP || mode == EM_KVUP || mode == EM_UP) {
            float rsv[2][4];
#pragma unroll
            for (int ai = 0; ai < 2; ++ai)
#pragma unroll
                for (int m = 0; m < 4; ++m) { const size_t rw = ROWOF(ai, m);
                    rsv[ai][m] = mode == EM_QUP ? ssq_sum_sh<8>(SQ + rw * 8, fq) * (1.f / 512.f) : mode == EM_KVUP ? ssq_sum_sh<4>(SKV + rw * 4, fq) * (1.f / 256.f) : ssq_sum_sh<32>(SH1 + rw * 32, fq) * (1.f / 2048.f); }
#pragma unroll
            for (int ai = 0; ai < 2; ++ai)
#pragma unroll
                for (int m = 0; m < 4; ++m) rsv[ai][m] = rsqrtf(rsv[ai][m] + EPS);
            if (mode == EM_QUP) {
                const int g0 = (u.pn * 8 + wc) % 6, g1 = (u.pn * 8 + 4 + wc) % 6;
#pragma unroll
                for (int am = 0; am < 4; ++am) { const int ai = am >> 1, mb = (am & 1) * 2;
                    f32x4 tb[4][2][2];
#pragma unroll
                    for (int m = mb; m < mb + 2; ++m)
#pragma unroll
                        for (int bj = 0; bj < 2; ++bj) { const int g = bj ? g1 : g0;
                            if (g >= 4) { const float* tp = ROPE + ((ROWOF(ai, m) & (size_t)(SEQ - 1)) * 32 + (size_t)(((g - 4) * 32 + 8 * fq) >> 1)) * 2; tb[m][bj][0] = *(const f32x4*)tp; tb[m][bj][1] = *(const f32x4*)(tp + 4); } }
#pragma unroll
                    for (int m = mb; m < mb + 2; ++m) { const size_t rw = ROWOF(ai, m); const float rs = rsv[ai][m];
#pragma unroll
                        for (int bj = 0; bj < 2; ++bj) { const int col = colb + bj * HALF, g = bj ? g1 : g0; f32x4 v0 = acc[ai][bj][m][0] * rs, v1 = acc[ai][bj][m][1] * rs;
                            if (g >= 4) rope8v(v0, v1, tb[m][bj][0], tb[m][bj][1]);
                            *(u32x4*)(QM + rw * 1536 + col) = pack8(v0, v1); } }
                }
            } else if (mode == EM_KVUP) {
#pragma unroll
                for (int ai = 0; ai < 2; ++ai)
#pragma unroll
                    for (int m = 0; m < 4; ++m) { const size_t rw = ROWOF(ai, m); const float rs = rsv[ai][m];
#pragma unroll
                        for (int bj = 0; bj < 2; ++bj) { const int col = colb + bj * HALF; const f32x4 v0 = acc[ai][bj][m][0] * rs, v1 = acc[ai][bj][m][1] * rs;
                            if (u.pn < 4) *(u32x4*)(KN + rw * 1024 + col) = pack8(v0, v1); else *(u32x4*)(VM + rw * 1024 + (col - 1024)) = pack8(v0, v1); } }
            } else {
#pragma unroll
                for (int ai = 0; ai < 2; ++ai)
#pragma unroll
                    for (int m = 0; m < 4; ++m) { const size_t rw = ROWOF(ai, m); const float rs = rsv[ai][m];
#pragma unroll
                        for (int bj = 0; bj < 2; ++bj) { const int col = colb + bj * HALF; f32x4 v0 = acc[ai][bj][m][0], v1 = acc[ai][bj][m][1];
#pragma unroll
                            for (int i = 0; i < 4; ++i) { float a = fmaxf(v0[i], 0.f) * rs, b = fmaxf(v1[i], 0.f) * rs; v0[i] = a * a; v1[i] = b * b; }
                            *(u32x4*)(U + rw * 8192 + col) = pack8(v0, v1); } }
            }
        } else if (mode == EM_BR1) {
            u32x4 gt[2][4][2];
#pragma unroll
            for (int ai = 0; ai < 2; ++ai)
#pragma unroll
                for (int m = 0; m < 4; ++m)
#pragma unroll
                    for (int bj = 0; bj < 2; ++bj) gt[ai][m][bj] = *(const u32x4*)(GATES + ROWOF(ai, m) * 4096 + colb + bj * HALF);
#pragma unroll
            for (int ai = 0; ai < 2; ++ai)
#pragma unroll
                for (int m = 0; m < 4; ++m)
#pragma unroll
                    for (int bj = 0; bj < 2; ++bj) { f32x4 g0, g1; unpack8(gt[ai][m][bj], g0, g1);
                        *(u32x4*)(TMP + ROWOF(ai, m) * 2048 + colb + bj * HALF) = pack8(acc[ai][bj][m][0] * g0, acc[ai][bj][m][1] * g1); }
        } else if (mode == EM_BR2) {
#pragma unroll
            for (int ai = 0; ai < 2; ++ai) {
                u32x4 gt[4][2], tt[4][2];
#pragma unroll
                for (int m = 0; m < 4; ++m)
#pragma unroll
                    for (int bj = 0; bj < 2; ++bj) { gt[m][bj] = *(const u32x4*)(GATES + ROWOF(ai, m) * 4096 + 2048 + colb + bj * HALF); tt[m][bj] = *(const u32x4*)(TMP + ROWOF(ai, m) * 2048 + colb + bj * HALF); }
#pragma unroll
                for (int m = 0; m < 4; ++m)
#pragma unroll
                    for (int bj = 0; bj < 2; ++bj) { f32x4 g0, g1, t0, t1; unpack8(gt[m][bj], g0, g1); unpack8(tt[m][bj], t0, t1);
                        *(u32x4*)(MIX + ROWOF(ai, m) * 2048 + colb + bj * HALF) = pack8(t0 + acc[ai][bj][m][0] * g0, t1 + acc[ai][bj][m][1] * g1); }
            }
        } else if (mode == EM_DOWN && !fuse8) {
#pragma unroll
            for (int ai = 0; ai < 2; ++ai)
#pragma unroll
                for (int m = 0; m < 4; ++m) { const size_t rw = ROWOF(ai, m); float ss = 0.f;
#pragma unroll
                    for (int bj = 0; bj < 2; ++bj) { const size_t o = rw * 2048 + colb + bj * HALF; f32x4 r0, r1; unpack8(*(const u32x4*)(H1B + o), r0, r1); const f32x4 h0 = r0 + acc[ai][bj][m][0], h1 = r1 + acc[ai][bj][m][1];
                        *(f32x4*)(OUT + o) = h0; *(f32x4*)(OUT + o + 4) = h1; ss += sumsq8(h0, h1); }
                    ssq_commit(SH2 + rw * 32 + u.pn * 4 + wc, ss, fq); }
        } else if (mode == EM_OUT) {
            const float* RES = X;
#pragma unroll
            for (int ai = 0; ai < 2; ++ai) {
                f32x4 xin[4][2][2];
#pragma unroll
                for (int m = 0; m < 4; ++m)
#pragma unroll
                    for (int bj = 0; bj < 2; ++bj) { const size_t o = ROWOF(ai, m) * 2048 + colb + bj * HALF; xin[m][bj][0] = *(const f32x4*)(RES + o); xin[m][bj][1] = *(const f32x4*)(RES + o + 4); }
#pragma unroll
                for (int m = 0; m < 4; ++m) { const size_t rw = ROWOF(ai, m); float ss = 0.f;
#pragma unroll
                    for (int bj = 0; bj < 2; ++bj) { const size_t o = rw * 2048 + colb + bj * HALF; const f32x4 h0 = xin[m][bj][0] + acc[ai][bj][m][0], h1 = xin[m][bj][1] + acc[ai][bj][m][1];
                        *(u32x4*)(H1B + o) = pack8(h0, h1); ss += sumsq8(h0, h1); }
                    ssq_commit(SH1 + rw * 32 + u.pn * 4 + wc, ss, fq); }
            }
        } else {
#pragma unroll
            for (int ai = 0; ai < 2; ++ai) {
                u32x4 xin[4][2];
#pragma unroll
                for (int m = 0; m < 4; ++m)
#pragma unroll
                    for (int bj = 0; bj < 2; ++bj) xin[m][bj] = *(const u32x4*)(H1B + ROWOF(ai, m) * 2048 + colb + bj * HALF);
#pragma unroll
                for (int m = 0; m < 4; ++m) { float ss = 0.f;
#pragma unroll
                    for (int bj = 0; bj < 2; ++bj) { f32x4 r0, r1; unpack8(xin[m][bj], r0, r1); acc[ai][bj][m][0] += r0; acc[ai][bj][m][1] += r1; ss += sumsq8(acc[ai][bj][m][0], acc[ai][bj][m][1]); }
                    ssq_commit(SH2 + ROWOF(ai, m) * 32 + u.pn * 4 + wc, ss, fq); } }
            asm volatile("s_waitcnt vmcnt(0)" ::: "memory");
            unsigned* c = PCNT + 64 * u.pm;
            if (fr == 0 && fq == 0) __hip_atomic_fetch_add(c, 1u, __ATOMIC_RELAXED, __HIP_MEMORY_SCOPE_AGENT);
            { unsigned sp = 0u; while (__hip_atomic_load(c, __ATOMIC_RELAXED, __HIP_MEMORY_SCOPE_AGENT) < 64u) { __builtin_amdgcn_s_sleep(1); if (++sp > (1u << 24)) break; } }
            __builtin_amdgcn_fence(__ATOMIC_ACQUIRE, "agent"); asm volatile("s_waitcnt vmcnt(0)" ::: "memory");
            f32x4 gv[2][2];
#pragma unroll
            for (int bj = 0; bj < 2; ++bj) { gv[bj][0] = *(const f32x4*)(GN + colb + bj * HALF); gv[bj][1] = *(const f32x4*)(GN + colb + bj * HALF + 4); }
#pragma unroll
            for (int ai = 0; ai < 2; ++ai)
#pragma unroll
                for (int m = 0; m < 4; ++m) { const size_t rw = ROWOF(ai, m); const float rs = rsqrtf(ssq_sum_sh<32>(SH2 + rw * 32, fq) * (1.f / 2048.f) + EPS);
#pragma unroll
                    for (int bj = 0; bj < 2; ++bj) { const size_t o = rw * 2048 + colb + bj * HALF;
                        *(f32x4*)(OUT + o) = acc[ai][bj][m][0] * rs * gv[bj][0]; *(f32x4*)(OUT + o + 4) = acc[ai][bj][m][1] * rs * gv[bj][1]; } }
        }
#undef ROWOF
    }
};
template <class Epi, class Sched, bool ALIGN_EPI = false, bool SP2 = false>
__device__ __forceinline__ void gemm_phase(PG8_LAS unsigned char* lds, const Gemm g, const Sched& S, const Epi& E) {
    int tid_ = threadIdx.x; asm volatile("" : "+v"(tid_));
    const int tid = tid_, wid = __builtin_amdgcn_readfirstlane(tid >> 6), lane = tid & 63, wr = wid >> 2, wc = wid & 3, fr = lane & 15, fq = lane >> 4;
    const int K = g.K, nt = K / BK;
    unsigned voffA[2], voffB[2];
#pragma unroll
    for (int i = 0; i < 2; ++i) { int R, C; stage_rc(tid * 16 + i * 8192, R, C); const int Rb = Epi::PERM ? ((R & ~31) + perm32(R & 31)) : R;
        voffA[i] = (unsigned)(R * K + C) * 2u; voffB[i] = (unsigned)(Rb * K + C) * 2u; }
    const size_t kstep = (size_t)(BK * 2);
    const size_t hstep = (size_t)HALF * K * 2;
    const size_t tstep = 2 * hstep;
    const unsigned ldsw = (unsigned)wid * 1024u;
    const int aoff = lds_byte(wr * 64 + fr, fq * 8), boff = lds_byte(wc * 32 + fr, fq * 8);
#define PG8_SA(b, h) (((b) * 2 + (h)) * HTB)
#define PG8_SB(b, h) ((4 + (b) * 2 + (h)) * HTB)
#define PG8_STAGE(bufoff, gbase, voff) do { _Pragma("unroll") for (int _i = 0; _i < 2; ++_i) \
        __builtin_amdgcn_global_load_lds((const unsigned*)((const char*)(gbase) + (voff)[_i]), (PG8_LAS unsigned*)(lds + (bufoff) + ldsw + _i * 8192), 16, 0, 0); } while (0)
#define PG8_LDA(dst, b, h) do { _Pragma("unroll") for (int m = 0; m < 4; ++m) _Pragma("unroll") for (int k = 0; k < 2; ++k) dst[m][k] = *(const PG8_LAS bf16x8*)(lds + PG8_SA(b, h) + aoff + m * 2048 + k * 1024); } while (0)
#define PG8_LDB(dst, b, h) do { _Pragma("unroll") for (int n = 0; n < 2; ++n) _Pragma("unroll") for (int k = 0; k < 2; ++k) dst[n][k] = *(const PG8_LAS bf16x8*)(lds + PG8_SB(b, h) + boff + n * 2048 + k * 1024); } while (0)
#define PG8_MMA(ai, bj, At, Bt) do { __builtin_amdgcn_s_setprio(1); _Pragma("unroll") for (int m = 0; m < 4; ++m) _Pragma("unroll") for (int n = 0; n < 2; ++n) _Pragma("unroll") for (int k = 0; k < 2; ++k) \
        acc[ai][bj][m][n] = __builtin_amdgcn_mfma_f32_16x16x32_bf16(Bt[n][k], At[m][k], acc[ai][bj][m][n], 0, 0, 0); __builtin_amdgcn_s_setprio(0); } while (0)
#define PG8_WAIT_V(n) asm volatile("s_waitcnt vmcnt(" #n ")" ::: "memory")
#define PG8_WAIT_L(n) asm volatile("s_waitcnt lgkmcnt(" #n ")" ::: "memory")
#define PG8_BAR __builtin_amdgcn_s_barrier()
#define PG8_SCHED __builtin_amdgcn_sched_barrier(0)
    Unit cur, nxt; int ui = 0;
    if (!S.next(0, cur)) return;
    f32x4 acc[2][2][4][2];
#pragma unroll
    for (int a = 0; a < 2; ++a)
#pragma unroll
        for (int b = 0; b < 2; ++b)
#pragma unroll
            for (int m = 0; m < 4; ++m)
#pragma unroll
                for (int n = 0; n < 2; ++n) acc[a][b][m][n] = (f32x4){0.f, 0.f, 0.f, 0.f};
    bf16x8 At[4][2], B0[2][2], B1[2][2];
    const char* cA = (const char*)g.A + (size_t)cur.pm * tstep; const char* cB = (const char*)g.Bt + (size_t)cur.pn * tstep;
    S.a_ready(cur);
    if constexpr (SP2) {
        PG8_STAGE(PG8_SB(0, 0), cB, voffB); PG8_STAGE(PG8_SB(0, 1), cB + hstep, voffB); PG8_STAGE(PG8_SA(0, 0), cA, voffA); PG8_STAGE(PG8_SA(0, 1), cA + hstep, voffA);
        if (wr == 1) PG8_BAR;
        PG8_WAIT_V(2); PG8_BAR;
        PG8_STAGE(PG8_SB(1, 0), cB + kstep, voffB); PG8_STAGE(PG8_SA(1, 0), cA + kstep, voffA); PG8_STAGE(PG8_SB(1, 1), cB + hstep + kstep, voffB);
        PG8_WAIT_V(6); PG8_BAR;
    } else {
        PG8_STAGE(PG8_SB(0, 0), cB, voffB); PG8_STAGE(PG8_SA(0, 0), cA, voffA); PG8_STAGE(PG8_SB(0, 1), cB + hstep, voffB); PG8_STAGE(PG8_SA(0, 1), cA + hstep, voffA);
        if (wr == 1) PG8_BAR;
        PG8_WAIT_V(4); PG8_BAR;
        PG8_STAGE(PG8_SB(1, 0), cB + kstep, voffB); PG8_STAGE(PG8_SA(1, 0), cA + kstep, voffA); PG8_STAGE(PG8_SB(1, 1), cB + hstep + kstep, voffB);
        PG8_WAIT_V(6); PG8_BAR;
    }
    for (;;) {
        const bool has_next = S.next(ui + 1, nxt);
        const char* nA = has_next ? (const char*)g.A + (size_t)nxt.pm * tstep : cA; const char* nB = has_next ? (const char*)g.Bt + (size_t)nxt.pn * tstep : cB;
        for (int t = 0; t < nt; t += 2) {
            const bool last = (t == nt - 2);
            const char* a1 = cA + (size_t)(t + 1) * kstep;
            const char* a2 = last ? nA : cA + (size_t)(t + 2) * kstep; const char* b2 = last ? nB : cB + (size_t)(t + 2) * kstep;
            const char* a3 = a2 + kstep; const char* b3 = b2 + kstep;
            if (last && has_next) S.a_ready(nxt);
            if constexpr (SP2) {
            PG8_LDB(B0, 0, 0); PG8_LDB(B1, 0, 1); PG8_SCHED; PG8_LDA(At, 0, 0); PG8_STAGE(PG8_SA(1, 1), a1 + hstep, voffA);
            PG8_WAIT_V(8); PG8_WAIT_L(0); PG8_BAR; PG8_MMA(0, 0, At, B0); PG8_MMA(0, 1, At, B1); PG8_BAR; PG8_SCHED;
            PG8_LDA(At, 0, 1); PG8_STAGE(PG8_SB(0, 0), b2, voffB); PG8_STAGE(PG8_SB(0, 1), b2 + hstep, voffB); PG8_STAGE(PG8_SA(0, 0), a2, voffA);
            PG8_WAIT_V(8); PG8_WAIT_L(0); PG8_BAR; PG8_MMA(1, 0, At, B0); PG8_MMA(1, 1, At, B1); PG8_BAR; PG8_SCHED;
            PG8_LDB(B0, 1, 0); PG8_LDB(B1, 1, 1); PG8_SCHED; PG8_LDA(At, 1, 0); PG8_STAGE(PG8_SA(0, 1), a2 + hstep, voffA);
            PG8_WAIT_V(8); PG8_WAIT_L(0); PG8_BAR; PG8_MMA(0, 0, At, B0); PG8_MMA(0, 1, At, B1); PG8_BAR; PG8_SCHED;
            PG8_LDA(At, 1, 1); PG8_STAGE(PG8_SB(1, 0), b3, voffB); PG8_STAGE(PG8_SB(1, 1), b3 + hstep, voffB); PG8_STAGE(PG8_SA(1, 0), a3, voffA);
            PG8_WAIT_V(8); PG8_WAIT_L(0); PG8_BAR; PG8_MMA(1, 0, At, B0); PG8_MMA(1, 1, At, B1); PG8_BAR; PG8_SCHED;
            } else {
            PG8_LDB(B0, 0, 0); PG8_SCHED; PG8_LDA(At, 0, 0); PG8_STAGE(PG8_SA(1, 1), a1 + hstep, voffA);
            PG8_WAIT_L(8); PG8_BAR; PG8_WAIT_L(0); PG8_MMA(0, 0, At, B0); PG8_BAR; PG8_SCHED;
            PG8_LDB(B1, 0, 1); PG8_STAGE(PG8_SB(0, 0), b2, voffB);
            PG8_BAR; PG8_WAIT_L(0); PG8_MMA(0, 1, At, B1); PG8_BAR;
            PG8_LDA(At, 0, 1); PG8_STAGE(PG8_SA(0, 0), a2, voffA);
            PG8_BAR; PG8_WAIT_L(0); PG8_MMA(1, 0, At, B0); PG8_BAR; PG8_SCHED;
            PG8_STAGE(PG8_SB(0, 1), b2 + hstep, voffB);
            PG8_WAIT_V(6); PG8_BAR; PG8_MMA(1, 1, At, B1); PG8_BAR;
            PG8_LDB(B0, 1, 0); PG8_SCHED; PG8_LDA(At, 1, 0); PG8_STAGE(PG8_SA(0, 1), a2 + hstep, voffA);
            PG8_WAIT_L(8); PG8_BAR; PG8_WAIT_L(0); PG8_MMA(0, 0, At, B0); PG8_BAR; PG8_SCHED;
            PG8_LDB(B1, 1, 1); PG8_STAGE(PG8_SB(1, 0), b3, voffB);
            PG8_BAR; PG8_WAIT_L(0); PG8_MMA(0, 1, At, B1); PG8_BAR;
            PG8_LDA(At, 1, 1); PG8_STAGE(PG8_SA(1, 0), a3, voffA);
            PG8_BAR; PG8_WAIT_L(0); PG8_MMA(1, 0, At, B0); PG8_BAR; PG8_SCHED;
            PG8_STAGE(PG8_SB(1, 1), b3 + hstep, voffB);
            PG8_WAIT_V(6); PG8_BAR; PG8_MMA(1, 1, At, B1); PG8_BAR;
            }
        }
        if constexpr (ALIGN_EPI) { if (wr == 0) PG8_BAR; }
        if constexpr (!Epi::AFTER_DRAIN) { E(acc, cur, wr, wc, fr, fq); S.done(cur); }
        if (!has_next) break;
#pragma unroll
        for (int a = 0; a < 2; ++a)
#pragma unroll
            for (int b = 0; b < 2; ++b)
#pragma unroll
                for (int m = 0; m < 4; ++m)
#pragma unroll
                    for (int n = 0; n < 2; ++n) acc[a][b][m][n] = (f32x4){0.f, 0.f, 0.f, 0.f};
        cur = nxt; cA = nA; cB = nB; ++ui;
        if constexpr (ALIGN_EPI) { if (wr == 1) PG8_BAR; }
    }
    PG8_WAIT_V(0);
    if constexpr (!ALIGN_EPI) { if (wr == 0) PG8_BAR; }
    PG8_BAR;
    if constexpr (Epi::AFTER_DRAIN) { E.fused(acc, cur, wr, wc, fr, fq, lds, wid, lane); S.done(cur); }
#undef PG8_SA
#undef PG8_SB
#undef PG8_STAGE
#undef PG8_LDA
#undef PG8_LDB
#undef PG8_MMA
#undef PG8_WAIT_V
#undef PG8_WAIT_L
#undef PG8_BAR
#undef PG8_SCHED
}
}
#ifndef ATT_PIPE_FOX
#define ATT_PIPE_FOX 0
#endif
#ifndef ATT_PIPE_MLA
#define ATT_PIPE_MLA 0
#endif
namespace att {
using bf16 = __hip_bfloat16;
typedef short bf16x8 __attribute__((ext_vector_type(8)));
typedef short s16x4 __attribute__((ext_vector_type(4)));
typedef float f32x16 __attribute__((ext_vector_type(16)));
typedef float f32x4 __attribute__((ext_vector_type(4)));
typedef unsigned u32x4 __attribute__((ext_vector_type(4)));
constexpr int D = 128, NW = 8, QBLK = 32, KVBLK = 64, QB = NW * QBLK, LDKV = 1024, LDO = 1024;
constexpr int SHM_V = KVBLK * D * 2, SHM_K = KVBLK * D * 2, SHM_KR = KVBLK * 64 * 2;
constexpr int OFF_V = 0, OFF_K = 2 * SHM_V, OFF_KR = OFF_K + 2 * SHM_K, OFF_WS = OFF_KR + 2 * SHM_KR, OFF_BIAS = OFF_WS + NW * 64 * 4, LDS_BYTES = OFF_BIAS + 2 * 64 * 4;
constexpr float THR = 8.f;
template <int MODE> struct Cfg { static constexpr float SCALE = MODE ? 0.07216878364870322f : 0.08838834764831845f; static constexpr int QLD = MODE ? 1536 : 1024, NQ = MODE ? 12 : 8; };

#define KSWZ(row, colB) ((row) * 256 + ((colB) ^ (((row) & 7) << 4)))
#define SBAR() __builtin_amdgcn_sched_barrier(0)
__device__ __forceinline__ int v_st(int k, int c) { const int kk = (k & ~0xC) | ((k & 4) << 1) | ((k & 8) >> 1); return ((kk >> 3) * 4 + (c >> 5)) * 512 + ((kk & 7) * 32 + (c & 31)) * 2; }
__device__ __forceinline__ int v_rd_base(int lane) { return ((lane & 3) << 3) | (((lane >> 2) & 3) << 6) | (((lane >> 4) & 1) << 5) | (((lane >> 5) & 1) << 8); }
constexpr int v_rd_off(int d0, int ks, int half) { return d0 * 512 + ks * 4096 + half * 2048; }
__device__ __forceinline__ int crow(int r, int hi) { return (r & 3) + 8 * (r >> 2) + 4 * hi; }
__device__ __forceinline__ unsigned cvtpk(float lo, float hi) { unsigned r; asm volatile("v_cvt_pk_bf16_f32 %0, %1, %2" : "=v"(r) : "v"(lo), "v"(hi)); return r; }
__device__ __forceinline__ bf16x8 ld8(const bf16* p) { return *reinterpret_cast<const bf16x8*>(p); }
__device__ __forceinline__ void mask_tile(f32x16& p0, f32x16& p1, int dq) {
    const float NEG = -__builtin_inff();
#pragma unroll
    for (int r = 0; r < 16; ++r) { const int c = (r & 3) + 8 * (r >> 2); if (dq - c < 0) p0[r] = NEG; if (dq - c - 32 < 0) p1[r] = NEG; }
}
template <int MODE>
__device__ __forceinline__ void partialSM(f32x16& p0, f32x16& p1, float& m_reg, float& mn, float& alpha) {
    constexpr float SCALE = Cfg<MODE>::SCALE;
    float pmax = p0[0]; for (int r = 1; r < 16; ++r) pmax = fmaxf(pmax, p0[r]); for (int r = 0; r < 16; ++r) pmax = fmaxf(pmax, p1[r]);
    { auto rr = __builtin_amdgcn_permlane32_swap(__float_as_uint(pmax), __float_as_uint(pmax), false, false);
      pmax = fmaxf(__uint_as_float(rr[0]), __uint_as_float(rr[1])); }
    constexpr float C2 = 1.4426950408889634f * SCALE;
    if (__builtin_expect(__all((pmax - m_reg) * SCALE <= THR), 1)) { mn = m_reg; alpha = 1.f; }
    else { mn = fmaxf(m_reg, pmax); alpha = __builtin_amdgcn_exp2f((m_reg - mn) * C2); m_reg = mn; }
    const float mnL = -mn * C2;
    for (int r = 0; r < 16; ++r) p0[r] = fmaf(p0[r], C2, mnL); for (int r = 0; r < 16; ++r) p1[r] = fmaf(p1[r], C2, mnL);
    for (int r = 0; r < 16; ++r) p0[r] = __builtin_amdgcn_exp2f(p0[r]);
}
__device__ __forceinline__ void finishSM(f32x16& p0, f32x16& p1, float alpha, float& l_reg, bf16x8& pa0, bf16x8& pa1, bf16x8& pa2, bf16x8& pa3) {
    for (int r = 0; r < 16; ++r) p1[r] = __builtin_amdgcn_exp2f(p1[r]);
    float ps = 0; for (int r = 0; r < 16; ++r) ps += p0[r]; for (int r = 0; r < 16; ++r) ps += p1[r];
    { auto rr = __builtin_amdgcn_permlane32_swap(__float_as_uint(ps), __float_as_uint(ps), false, false);
      ps = __uint_as_float(rr[0]) + __uint_as_float(rr[1]); }
    l_reg = l_reg * alpha + ps;
#define PK4(P, B_, OUT) do { unsigned a0 = cvtpk(P[B_+0], P[B_+1]), a1 = cvtpk(P[B_+2], P[B_+3]);                          \
        unsigned b0 = cvtpk(P[B_+4], P[B_+5]), b1 = cvtpk(P[B_+6], P[B_+7]);                                             \
        auto r0 = __builtin_amdgcn_permlane32_swap(a0, b0, false, false); auto r1 = __builtin_amdgcn_permlane32_swap(a1, b1, false, false); \
        u32x4 w = {r0[0], r1[0], r0[1], r1[1]}; OUT = *reinterpret_cast<bf16x8*>(&w); } while (0)
    PK4(p0, 0, pa0); PK4(p0, 8, pa1); PK4(p1, 0, pa2); PK4(p1, 8, pa3);
#undef PK4
}
template <int KB, int MODE>
__device__ __forceinline__ void qkt(f32x16& p0, f32x16& p1, const char* lds, int r32, int hi, const bf16x8* qr, bool act) {
    if (MODE == 1 && !act) { const float NEG = -__builtin_inff();
#pragma unroll
        for (int r = 0; r < 16; ++r) { p0[r] = NEG; p1[r] = NEG; } return; }
    if (MODE == 0) { const float* bp = (const float*)(lds + OFF_BIAS) + KB * 64 + 4 * hi;
#pragma unroll
        for (int g = 0; g < 4; ++g) { const f32x4 a = *(const f32x4*)(bp + 8 * g), b = *(const f32x4*)(bp + 32 + 8 * g);
#pragma unroll
            for (int i = 0; i < 4; ++i) { p0[4 * g + i] = a[i]; p1[4 * g + i] = b[i]; } }
    } else { p0 = f32x16{}; p1 = f32x16{}; }
    int ko[4];
#pragma unroll
    for (int dd = 0; dd < 4; ++dd) ko[dd] = KSWZ(r32, (dd * 16 + hi * 8) * 2);
#pragma unroll
    for (int d0 = 0; d0 < 8; ++d0) { const char* a = lds + OFF_K + KB * SHM_K + ko[d0 & 3] + (d0 >> 2) * 128;
        bf16x8 b0 = *reinterpret_cast<const bf16x8*>(a);
        bf16x8 b1 = *reinterpret_cast<const bf16x8*>(a + 32 * 256);
        p0 = __builtin_amdgcn_mfma_f32_32x32x16_bf16(b0, qr[d0], p0, 0, 0, 0);
        p1 = __builtin_amdgcn_mfma_f32_32x32x16_bf16(b1, qr[d0], p1, 0, 0, 0);
        if ((d0 & 3) == 3) SBAR(); }
    if (MODE == 1) {
#pragma unroll
        for (int d0 = 0; d0 < 4; ++d0) { const char* a = lds + OFF_KR + KB * SHM_KR + ko[d0];
            bf16x8 b0 = *reinterpret_cast<const bf16x8*>(a);
            bf16x8 b1 = *reinterpret_cast<const bf16x8*>(a + 128);
            p0 = __builtin_amdgcn_mfma_f32_32x32x16_bf16(b0, qr[8 + d0], p0, 0, 0, 0);
            p1 = __builtin_amdgcn_mfma_f32_32x32x16_bf16(b1, qr[8 + d0], p1, 0, 0, 0); }
    }
}
template <int VB, bool SK>
__device__ __forceinline__ void pv_tile(f32x16* o, int vb0, bf16x8 pa0, bf16x8 pa1, bf16x8 pa2, bf16x8 pa3, bool act) {
    if (SK && !act) return;
#define TRRD(dst, off) asm volatile("ds_read_b64_tr_b16 %0, %1 offset:%2" : "=&v"(dst) : "v"(vb0), "i"(off) : "memory")
#define PV_D0(d0) do { s16x4 l0, l1, l2, l3, h0, h1, h2, h3; constexpr int b_ = VB * SHM_V + v_rd_off(d0, 0, 0); \
        TRRD(l0, b_); TRRD(h0, b_ + 2048); TRRD(l1, b_ + 4096); TRRD(h1, b_ + 6144); TRRD(l2, b_ + 8192); TRRD(h2, b_ + 10240); TRRD(l3, b_ + 12288); TRRD(h3, b_ + 14336); \
          \
        asm volatile("s_waitcnt lgkmcnt(6)" ::: "memory"); SBAR();   \
        o[d0] = __builtin_amdgcn_mfma_f32_32x32x16_bf16(pa0, (bf16x8){l0[0], l0[1], l0[2], l0[3], h0[0], h0[1], h0[2], h0[3]}, o[d0], 0, 0, 0); SBAR();  \
        asm volatile("s_waitcnt lgkmcnt(4)" ::: "memory"); SBAR();   \
        o[d0] = __builtin_amdgcn_mfma_f32_32x32x16_bf16(pa1, (bf16x8){l1[0], l1[1], l1[2], l1[3], h1[0], h1[1], h1[2], h1[3]}, o[d0], 0, 0, 0); SBAR();  \
        asm volatile("s_waitcnt lgkmcnt(2)" ::: "memory"); SBAR();   \
        o[d0] = __builtin_amdgcn_mfma_f32_32x32x16_bf16(pa2, (bf16x8){l2[0], l2[1], l2[2], l2[3], h2[0], h2[1], h2[2], h2[3]}, o[d0], 0, 0, 0); SBAR();  \
        asm volatile("s_waitcnt lgkmcnt(0)" ::: "memory"); SBAR();   \
        o[d0] = __builtin_amdgcn_mfma_f32_32x32x16_bf16(pa3, (bf16x8){l3[0], l3[1], l3[2], l3[3], h3[0], h3[1], h3[2], h3[3]}, o[d0], 0, 0, 0); } while (0)
    PV_D0(0); PV_D0(1); PV_D0(2); PV_D0(3);
#undef PV_D0
#undef TRRD
}

struct BlockRef { const bf16* Q; const bf16* K; const bf16* V; bf16* O; const bf16* KR; const float* BIAS; int P0; };
template <int MODE> struct Seam { bf16x8 qr[Cfg<MODE>::NQ]; bf16x8 st_v0, st_v1, st_k0, st_k1, st_kr; float st_b; };

#define ROWKV(p, k0, rr) ((p) + (size_t)((k0) + (rr)) * LDKV + sc)
#define VMW() asm volatile("s_waitcnt vmcnt(0)" ::: "memory")
#define VMWN(n) asm volatile("s_waitcnt vmcnt(%0)" :: "i"(n) : "memory")
#define SLOAD(R, k0) do { S.st_v0 = ld8(ROWKV((R).V, k0, sr)); S.st_v1 = ld8(ROWKV((R).V, k0, 32 + sr));              \
                          S.st_k0 = ld8(ROWKV((R).K, k0, sr)); S.st_k1 = ld8(ROWKV((R).K, k0, 32 + sr));              \
                          if (MODE == 1) S.st_kr = ld8((R).KR + (size_t)((k0) + (tid >> 3)) * 64 + (tid & 7) * 8);       \
                          if (MODE == 0) { if (tid < 64) S.st_b = (R).BIAS[(k0) + tid]; } } while (0)
#define SWRITE_K(bf) do { *(bf16x8*)(lds + OFF_K + (bf) * SHM_K + kws) = S.st_k0; *(bf16x8*)(lds + OFF_K + (bf) * SHM_K + kws + 32 * 256) = S.st_k1; \
                          if (MODE == 1) *(bf16x8*)(lds + OFF_KR + (bf) * SHM_KR + krws) = S.st_kr;                       \
                          if (MODE == 0) { if (tid < 64) ((float*)(lds + OFF_BIAS))[(bf) * 64 + tid] = S.st_b; } } while (0)
#define SWRITE_V(bf) do { *(bf16x8*)(lds + OFF_V + (bf) * SHM_V + vst0) = S.st_v0; *(bf16x8*)(lds + OFF_V + (bf) * SHM_V + vst1) = S.st_v1; } while (0)
#define SWRITE_KV(bf) do { SWRITE_V(bf); SWRITE_K(bf); } while (0)
#define QLOAD(R) do { _Pragma("unroll") for (int d0 = 0; d0 < 8; ++d0) S.qr[d0] = ld8((R).Q + (size_t)(wid * QBLK + r32) * Cfg<MODE>::QLD + d0 * 16 + hi * 8);   \
                      if (MODE == 1) { _Pragma("unroll") for (int d0 = 0; d0 < 4; ++d0) S.qr[(MODE ? 8 : 0) + d0] = ld8((R).Q + (size_t)(wid * QBLK + r32) * Cfg<MODE>::QLD + 128 + d0 * 16 + hi * 8); } } while (0)

template <int MODE>
__device__ __forceinline__ void attn_block_np(const BlockRef& cur, char* lds) {
    int tid_ = threadIdx.x; asm volatile("" : "+v"(tid_));
    const int tid = tid_, wid = __builtin_amdgcn_readfirstlane(tid >> 6), lane = tid & 63, r32 = lane & 31, hi = lane >> 5;
    const int NT = (cur.P0 + QB) / KVBLK;
    const int qlo = cur.P0 + wid * QBLK, qm = qlo + r32 - 4 * hi;
    float* ws = (float*)(lds + OFF_WS) + wid * 64; float* li_l = ws, * al_l = ws + 32;
    float m_reg = -1e30f, l_reg = 0; f32x16 o[4] = {};
    const int sr = tid >> 4, sc = (tid & 15) * 8, vst0 = v_st(sr, sc), vst1 = v_st(32 + sr, sc), kws = KSWZ(sr, sc * 2), krws = KSWZ((tid >> 3) & 31, ((tid >> 8) * 64 + (tid & 7) * 8) * 2);
    const int vb0 = (int)(uintptr_t)(lds + OFF_V) + v_rd_base(lane);
    Seam<MODE> S;
    QLOAD(cur);
    SLOAD(cur, 0); VMW(); SWRITE_KV(0);
    __syncthreads();
#define RESC(a) do { if (__any((a) < 1.f)) { if (hi == 0) al_l[r32] = (a); asm volatile("s_waitcnt lgkmcnt(0)" ::: "memory");              \
                     for (int d_ = 0; d_ < 4; ++d_) for (int r = 0; r < 16; ++r) o[d_][r] *= al_l[crow(r, hi)]; } } while (0)
#define KBASE(t) ((t) * KVBLK)
#define ACT(t) (MODE == 1 ? ((t) <= (qlo >> 6)) : (KBASE(t) <= qlo + QBLK - 1))
#define MASKT(P0_, P1_, t) do { if (MODE == 0) { const int kb_ = KBASE(t); if (kb_ + KVBLK - 1 > qlo) mask_tile(P0_, P1_, qm - kb_); } } while (0)
    f32x16 p0, p1; float mn, al; bf16x8 pa0, pa1, pa2, pa3;
#define STEP(t, KB) do {                                                                                                       \
        if ((t) + 1 < NT) { SLOAD(cur, KBASE((t) + 1)); }                                                                      \
        SBAR();                                                                                                                \
        if (ACT(t)) {                                                                                                          \
            qkt<KB, MODE>(p0, p1, lds, r32, hi, S.qr, true);                                                                   \
            MASKT(p0, p1, (t)); partialSM<MODE>(p0, p1, m_reg, mn, al); RESC(al);                                              \
            finishSM(p0, p1, al, l_reg, pa0, pa1, pa2, pa3); SBAR();                                                           \
            pv_tile<KB, false>(o, vb0, pa0, pa1, pa2, pa3, true);                                                              \
        }                                                                                                                      \
        SBAR();                                                                                                                \
        if ((t) + 1 < NT) { VMW(); SWRITE_KV((KB) ^ 1); }                                                                      \
        __syncthreads(); } while (0)
    for (int t = 0; t < NT; t += 2) { STEP(t, 0); STEP(t + 1, 1); }
    if (hi == 0) li_l[r32] = l_reg; asm volatile("s_waitcnt lgkmcnt(0)" ::: "memory");
    float rli[16];
#pragma unroll
    for (int r = 0; r < 16; ++r) rli[r] = __builtin_amdgcn_rcpf(li_l[crow(r, hi)]);
    bf16* Ow = cur.O + (size_t)(wid * QBLK) * LDO;
    { char* stg = lds + wid * 8192;
#pragma unroll
      for (int r = 0; r < 16; ++r) { const int orow = crow(r, hi);
#pragma unroll
          for (int d0 = 0; d0 < 4; ++d0) { const float v = o[d0][r] * rli[r];
              const float vn = __shfl_xor(v, 1);
              if ((r32 & 1) == 0) *(unsigned*)(stg + orow * 256 + (d0 * 32 + r32) * 2) = cvtpk(v, vn); } }
      asm volatile("s_waitcnt lgkmcnt(0)" ::: "memory");
#pragma unroll
      for (int i = 0; i < 8; ++i) { const int row = 4 * i + (lane >> 4), ch = lane & 15; const u32x4 w = *(const u32x4*)(stg + row * 256 + ch * 16);
          *(u32x4*)(Ow + (size_t)row * LDO + ch * 8) = w; } }
    __syncthreads();
#undef RESC
#undef KBASE
#undef ACT
#undef MASKT
#undef STEP
}
#if ATT_PIPE_FOX || ATT_PIPE_MLA
template <int MODE>
__device__ __forceinline__ void attn_prime(const BlockRef& cur, char* lds, Seam<MODE>& S) {
    int tid_ = threadIdx.x; asm volatile("" : "+v"(tid_));
    const int tid = tid_, wid = __builtin_amdgcn_readfirstlane(tid >> 6), lane = tid & 63, r32 = lane & 31, hi = lane >> 5;
    const int sr = tid >> 4, sc = (tid & 15) * 8, kws = KSWZ(sr, sc * 2), krws = KSWZ((tid >> 3) & 31, ((tid >> 8) * 64 + (tid & 7) * 8) * 2);
    QLOAD(cur);
    SLOAD(cur, 0); VMW(); SWRITE_K(0);
    __syncthreads();
}
template <int MODE>
__device__ __forceinline__ void attn_block(const BlockRef& cur, const BlockRef& nxt, char* lds, Seam<MODE>& S) {
    constexpr bool SK = (MODE == 1);
    int tid_ = threadIdx.x; asm volatile("" : "+v"(tid_));
    const int tid = tid_, wid = __builtin_amdgcn_readfirstlane(tid >> 6), lane = tid & 63, r32 = lane & 31, hi = lane >> 5;
    const int NT = (cur.P0 + QB) / KVBLK;
    const int qlo = cur.P0 + wid * QBLK, qm = qlo + r32 - 4 * hi;
    float* ws = (float*)(lds + OFF_WS) + wid * 64; float* li_l = ws, * al_l = ws + 32;
    float m_reg = -1e30f, l_reg = 0; f32x16 o[4] = {};
    const int sr = tid >> 4, sc = (tid & 15) * 8, vst0 = v_st(sr, sc), vst1 = v_st(32 + sr, sc), kws = KSWZ(sr, sc * 2), krws = KSWZ((tid >> 3) & 31, ((tid >> 8) * 64 + (tid & 7) * 8) * 2);
    const int vb0 = (int)(uintptr_t)(lds + OFF_V) + v_rd_base(lane);
#define RESC(a) do { if (__any((a) < 1.f)) { if (hi == 0) al_l[r32] = (a); asm volatile("s_waitcnt lgkmcnt(0)" ::: "memory");              \
                     for (int d_ = 0; d_ < 4; ++d_) for (int r = 0; r < 16; ++r) o[d_][r] *= al_l[crow(r, hi)]; } } while (0)
#define KBASE(t) ((t) * KVBLK)
#define ACT(t) (!SK || ((t) <= (qlo >> 6)))
#define MASKT(P0_, P1_, t) do { if (MODE == 0) { const int kb_ = KBASE(t); if (kb_ + KVBLK - 1 > qlo) mask_tile(P0_, P1_, qm - kb_); } } while (0)
    constexpr int NQL = Cfg<MODE>::NQ;
#define SEAM_K0() do { VMWN(NQL); SWRITE_K(0); SBAR(); } while (0)
    f32x16 pA0, pA1, pB0, pB1; float mnA, mnB, alA, alB; bf16x8 pa0, pa1, pa2, pa3;
    SWRITE_V(0); SBAR();
    if (NT > 1) SLOAD(cur, KBASE(1));
    SBAR(); qkt<0, MODE>(pA0, pA1, lds, r32, hi, S.qr, ACT(0));
    MASKT(pA0, pA1, 0); partialSM<MODE>(pA0, pA1, m_reg, mnA, alA);
    if (NT > 1) { VMW(); SWRITE_KV(1); }
    __syncthreads();
#define HALF_STEP(PX0, PX1, mnX, alX, PY0, PY1, alY, t, KB, VB, SB) do {                                                      \
        SBAR(); qkt<KB, MODE>(PX0, PX1, lds, r32, hi, S.qr, ACT(t));                                             \
        finishSM(PY0, PY1, alY, l_reg, pa0, pa1, pa2, pa3); SBAR();                                                           \
        if ((t) + 1 < NT) { SLOAD(cur, KBASE((t) + 1)); SBAR(); }                                               \
        pv_tile<VB, SK>(o, vb0, pa0, pa1, pa2, pa3, ACT((t) - 1)); MASKT(PX0, PX1, (t)); partialSM<MODE>(PX0, PX1, m_reg, mnX, alX);      \
        __syncthreads();                                                                                                      \
        if ((t) + 1 < NT) { VMW(); SWRITE_KV(SB); }                                                                          \
        RESC(alX); __syncthreads(); } while (0)
    for (int t = 1; t + 1 < NT; t += 2) {
        HALF_STEP(pB0, pB1, mnB, alB, pA0, pA1, alA, t, 1, 0, 0);
        HALF_STEP(pA0, pA1, mnA, alA, pB0, pB1, alB, t + 1, 0, 1, 1);
    }
    const bool even = (NT & 1) == 0;
    if (even) { SBAR(); qkt<1, MODE>(pB0, pB1, lds, r32, hi, S.qr, ACT(NT - 1)); SBAR(); }
    SLOAD(nxt, 0); SBAR();
    QLOAD(nxt);
    SBAR();
    finishSM(pA0, pA1, alA, l_reg, pa0, pa1, pa2, pa3); SBAR();
    pv_tile<0, SK>(o, vb0, pa0, pa1, pa2, pa3, ACT(even ? NT - 2 : NT - 1));
    if (even) { MASKT(pB0, pB1, NT - 1); partialSM<MODE>(pB0, pB1, m_reg, mnB, alB); __syncthreads(); RESC(alB);
        finishSM(pB0, pB1, alB, l_reg, pa0, pa1, pa2, pa3); SBAR(); pv_tile<1, SK>(o, vb0, pa0, pa1, pa2, pa3, ACT(NT - 1)); }
    SBAR(); SEAM_K0();
    if (hi == 0) li_l[r32] = l_reg; asm volatile("s_waitcnt lgkmcnt(0)" ::: "memory");
    float rli[16];
#pragma unroll
    for (int r = 0; r < 16; ++r) rli[r] = __builtin_amdgcn_rcpf(li_l[crow(r, hi)]);
    bf16* Ow = cur.O + (size_t)(wid * QBLK) * LDO;
#pragma unroll
    for (int r = 0; r < 16; ++r) { const int orow = crow(r, hi);
#pragma unroll
        for (int d0 = 0; d0 < 4; ++d0) { const float v = o[d0][r] * rli[r];
            const float vn = __shfl_xor(v, 1);
            if ((r32 & 1) == 0) *(unsigned*)(Ow + (size_t)orow * LDO + d0 * 32 + r32) = cvtpk(v, vn); } }
    __syncthreads();
#undef RESC
#undef KBASE
#undef ACT
#undef MASKT
#undef SEAM_K0
#undef HALF_STEP
}
#endif
#undef ROWKV
#undef VMW
#undef VMWN
#undef SLOAD
#undef SWRITE_K
#undef SWRITE_V
#undef SWRITE_KV
#undef QLOAD
#undef KSWZ
#undef SBAR
}
#define GAS __attribute__((address_space(1)))
#define LAS __attribute__((address_space(3)))
typedef unsigned short bf16b;
typedef unsigned v4u __attribute__((ext_vector_type(4)));
typedef float f32x4 __attribute__((ext_vector_type(4)));
constexpr size_t MiB = 1u << 20;
constexpr size_t WS_SQ = 1008 * MiB, WS_SKV = 1009 * MiB, WS_SH1 = 1010 * MiB, WS_SH2 = 1014 * MiB;
constexpr size_t WS_ROPE = 1 * MiB;
constexpr size_t WS_WIN = 4 * MiB, WS_WUQ = 36 * MiB, WS_WUKV = 38 * MiB, WS_WM = 40 * MiB, WS_WF = 44 * MiB, WS_WOUT = 48 * MiB, WS_WUP = 56 * MiB, WS_WDOWN = 88 * MiB;
constexpr size_t WS_XN = 120 * MiB;
constexpr size_t WS_CQ = 248 * MiB, WS_CKV = 280 * MiB, WS_KR = 296 * MiB, WS_FF = 300 * MiB, WS_BIAS = 301 * MiB;
constexpr size_t WS_FQ = 304 * MiB;
constexpr size_t WS_GATES = 496 * MiB;
constexpr size_t WS_KN = 752 * MiB, WS_VM = 816 * MiB, WS_OM = 880 * MiB, WS_OF = 944 * MiB, WS_END = 1018 * MiB;
constexpr size_t WS_U = 432 * MiB;
constexpr int LDS_TOTAL = 131072 + 1024;
static_assert(att::LDS_BYTES <= 131072, "attention LDS");

#define XB_TMO      128
#define XB_XCNT(j)  (256  + 64 * (j))
#define XB_XSUB(j)  (1280 + 64 * (j))
#define XB_XGEN(j)  (2304 + 64 * (j))
#define XB_TOP      3328
#define XB_TOPGEN   3392
#define XCD_BAR_WORDS 3456
#define XB_SPIN_CAP (1u << 18)

__device__ __forceinline__ unsigned xb_ld(unsigned* p)              { return __hip_atomic_load(p, __ATOMIC_RELAXED, __HIP_MEMORY_SCOPE_AGENT); }
__device__ __forceinline__ unsigned xb_add(unsigned* p, unsigned v) { return __hip_atomic_fetch_add(p, v, __ATOMIC_RELAXED, __HIP_MEMORY_SCOPE_AGENT); }
__device__ __forceinline__ unsigned xb_xcc_id() { return (unsigned)__builtin_amdgcn_s_getreg((3 << 11) | 20) & 0xFu; }
#define XB_SPIN(cond, bar) do { unsigned _sp = 0; while (cond) { __builtin_amdgcn_s_sleep(1); \
    if ((++_sp & 255u) == 0u) { if (xb_ld(&(bar)[XB_TMO])) break; if (_sp > XB_SPIN_CAP) { atomicAdd(&(bar)[XB_TMO], 1u); break; } } } } while (0)

struct XcdBarrier {
    unsigned* bar; unsigned x;
    volatile LAS unsigned* st;
};

__device__ __forceinline__ XcdBarrier xcd_barrier_post(unsigned* bar, volatile LAS unsigned* st) {
    XcdBarrier b; b.bar = bar; b.x = xb_xcc_id(); b.st = st;
    if (threadIdx.x == 0) (void)xb_add(&bar[XB_XCNT(b.x)], 1u);
    return b;
}
__device__ __forceinline__ void xcd_barrier_complete(unsigned* bar, unsigned x, unsigned& nloc, unsigned& nx) {
    const unsigned G = gridDim.x * gridDim.y * gridDim.z;
    unsigned sum, cnt, mine, sp = 0u;
    for (;;) {
        sum = 0u; cnt = 0u; mine = 0u;
#pragma unroll
        for (unsigned j = 0; j < 16; ++j) { const unsigned c = xb_ld(&bar[XB_XCNT(j)]); sum += c; cnt += (c > 0u) ? 1u : 0u; mine = (j == x) ? c : mine; }
        if (sum == G) break;
        __builtin_amdgcn_s_sleep(1);
        if ((++sp & 255u) == 0u) { if (xb_ld(&bar[XB_TMO])) break; if (sp > XB_SPIN_CAP) { atomicAdd(&bar[XB_TMO], 1u); break; } }
    }
    nloc = mine > 0u ? mine : 1u; nx = cnt > 0u ? cnt : 1u;
}

__device__ __forceinline__ void xcd_barrier(const XcdBarrier& b) {
    asm volatile("s_waitcnt vmcnt(0)" ::: "memory");
    __syncthreads();
    if (threadIdx.x == 0) {
        unsigned* bar = b.bar;
        __builtin_amdgcn_s_waitcnt(0);
        unsigned nloc = b.st[0], nx = b.st[1];
        if (nloc == 0u) { xcd_barrier_complete(bar, b.x, nloc, nx); b.st[0] = nloc; b.st[1] = nx; }
        const unsigned old = xb_add(&bar[XB_XSUB(b.x)], 1u);
        const unsigned gen = old / nloc;
        if (old + 1u == (gen + 1u) * nloc) {
            __builtin_amdgcn_fence(__ATOMIC_RELEASE, "agent");
            asm volatile("s_waitcnt vmcnt(0)" ::: "memory");
            const unsigned og = xb_add(&bar[XB_TOP], 1u);
            const unsigned tg = og / nx;
            if (og + 1u == (tg + 1u) * nx) xb_add(&bar[XB_TOPGEN], 1u);
            else XB_SPIN(xb_ld(&bar[XB_TOPGEN]) == tg, bar);
            __builtin_amdgcn_fence(__ATOMIC_ACQUIRE, "agent");
            xb_add(&bar[XB_XGEN(b.x)], 1u);
            asm volatile("s_waitcnt vmcnt(0)" ::: "memory");
        } else {
            XB_SPIN(xb_ld(&bar[XB_XGEN(b.x)]) == gen, bar);
            __builtin_amdgcn_fence(__ATOMIC_ACQUIRE, "agent");
            asm volatile("s_waitcnt vmcnt(0)" ::: "memory");
        }
    }
    __syncthreads();
}

constexpr size_t WS_PCNT = 3 * MiB + 512 * 1024;
constexpr size_t WS_BAR = 3 * MiB;

struct Own { int xi, nx, lr, nloc; };
#ifndef BATCH_MAP
#define BATCH_MAP 1
#endif
__device__ __forceinline__ int own_panel(const Own& o, int k) {
    if (BATCH_MAP && o.nx == 8 && MROWS / 256 == 128) { if (k >= 16) return 1 << 20; const int s = o.xi & 1, qb = s ? 8 + k : (k < 8 ? k : 16 + k); return 32 * (o.xi >> 1) + qb; }
    return k * o.nx + ((k & 1) ? o.nx - 1 - o.xi : o.xi); }
__device__ __forceinline__ int own_npan(const Own& o, int nM) { int n = 0; while (own_panel(o, n) < nM) ++n; return n; }
#ifndef XGM
#define XGM 4
#endif
struct XOrder {
    Own o; int nN, npan, nunits;
    __device__ __forceinline__ void init(int M, int N, const Own& o_) { o = o_; if (!OWN_GEMM) { o.nx = 8; o.nloc = gridDim.x / 8; o.xi = blockIdx.x % 8; o.lr = blockIdx.x / 8; } nN = N / 256; npan = own_npan(o, M / 256); nunits = npan * nN; }
    __device__ __forceinline__ bool next(int i, pg8::Unit& u) const {
        const int L = i * o.nloc + o.lr; if (L >= nunits) return false;
        const int nig = XGM * nN, gid = L / nig, fm = gid * XGM, gsz = (npan - fm) < XGM ? (npan - fm) : XGM, r = L - gid * nig;
        u.pm = own_panel(o, fm + r % gsz); u.pn = r / gsz; return true;
    }
    __device__ __forceinline__ void a_ready(const pg8::Unit&) const {}
    __device__ __forceinline__ void done(const pg8::Unit&) const {}
};
#ifndef CUT_MASK
#define CUT_MASK (MK_MULTI ? 0xff : 0)
#endif
struct Args { const float* in[15]; float* out; unsigned char* ws; int ph_lo, ph_hi, li, pad; };

__device__ __forceinline__ unsigned f2bf(float f) { unsigned u = __builtin_bit_cast(unsigned, f); return (u + 0x7fffu + ((u >> 16) & 1u)) >> 16; }
__device__ __forceinline__ unsigned pk2(float lo, float hi) { return f2bf(lo) | (f2bf(hi) << 16); }
__device__ __forceinline__ float wave_sum(float v) {
#pragma unroll
    for (int o = 1; o < 64; o <<= 1) v += __shfl_xor(v, o);
    return v;
}
__device__ __forceinline__ int map_col(int id, int j) {
    if (id == 1) { if (j < 768) return j; if (j < 832) { const int i = j - 768; return 768 + (i < 32 ? 2 * i : 2 * (i - 32) + 1); }
                   if (j < 3904) return 1024 + (j - 832); if (j < 3912) return 832 + (j - 3904); return 4096 + (j - 3912); }
    if (id == 2) { const int h = j / 192, r = j - h * 192; if (r < 128) return j; const int i = r - 128; return 192 * h + 128 + (i < 32 ? 2 * i : 2 * (i - 32) + 1); }
    if (id == 3) { const int h = j >> 8, r = j & 255; return r < 128 ? 128 * h + r : 1024 + 128 * h + (r - 128); }
    return j;
}
__device__ __forceinline__ void p0_transpose_item(const float* W, int K, int N, bf16b* WT, const float* gain, int mapid, LAS float* scr, int item, int lane) {
    const int nblk = (N + 31) / 32, kb = item / nblk, nb = item - kb * nblk, k0 = 64 * kb, n0 = 32 * nb;
    const int col = n0 + (lane & 31);
#pragma unroll 8
    for (int i = 0; i < 32; ++i) { const int kk = 2 * i + (lane >> 5); float v = 0.f; if (col < N) { v = W[(size_t)(k0 + kk) * N + col]; if (gain) v *= gain[k0 + kk]; } scr[kk * 33 + (lane & 31)] = v; }
    asm volatile("s_waitcnt lgkmcnt(0)" ::: "memory");
    const int c = lane & 7;
#pragma unroll
    for (int j = 0; j < 4; ++j) { const int n = (lane >> 3) + 8 * j; const LAS float* s = scr + (8 * c) * 33 + n;
        if (n0 + n < N) { v4u o; o.x = pk2(s[0 * 33], s[1 * 33]); o.y = pk2(s[2 * 33], s[3 * 33]); o.z = pk2(s[4 * 33], s[5 * 33]); o.w = pk2(s[6 * 33], s[7 * 33]);
            *(v4u*)(WT + (size_t)map_col(mapid, n0 + n) * K + k0 + 8 * c) = o; } }
    asm volatile("s_waitcnt lgkmcnt(0)" ::: "memory");
}


struct TDesc { const float* W; const float* gain; bf16b* WT; int K, N, mapid, item; };
__device__ __forceinline__ void p0_item_load(const TDesc& d, int lane, f32x4 (&v)[8], float (&g)[8]) {
    const int nblk = (d.N + 31) / 32, kb = d.item / nblk, nb = d.item - kb * nblk, k0 = 64 * kb, col = 32 * nb + 4 * (lane & 7), kr = lane >> 3;
#pragma unroll
    for (int i = 0; i < 8; ++i) { const int k = k0 + 8 * i + kr; v[i] = (f32x4){0.f, 0.f, 0.f, 0.f}; if (col < d.N) v[i] = *(const f32x4*)(d.W + (size_t)k * d.N + col); g[i] = d.gain ? d.gain[k] : 1.f; }
}
__device__ __forceinline__ void p0_item_store(const TDesc& d, int lane, const f32x4 (&v)[8], const float (&g)[8], LAS float* scr) {
    const int nblk = (d.N + 31) / 32, kb = d.item / nblk, nb = d.item - kb * nblk, k0 = 64 * kb, n0 = 32 * nb, kr = lane >> 3, c4 = lane & 7;
#pragma unroll
    for (int i = 0; i < 8; ++i) { LAS float* s = scr + (8 * i + kr) * 33 + 4 * c4; const f32x4 xv = v[i] * g[i]; s[0] = xv.x; s[1] = xv.y; s[2] = xv.z; s[3] = xv.w; }
    asm volatile("s_waitcnt lgkmcnt(0)" ::: "memory");
    const int c = lane & 7;
#pragma unroll
    for (int j = 0; j < 4; ++j) { const int n = (lane >> 3) + 8 * j; const LAS float* s = scr + (8 * c) * 33 + n;
        if (n0 + n < d.N) { v4u o; o.x = pg8::cvt_pk_bf16(s[0 * 33], s[1 * 33]); o.y = pg8::cvt_pk_bf16(s[2 * 33], s[3 * 33]); o.z = pg8::cvt_pk_bf16(s[4 * 33], s[5 * 33]); o.w = pg8::cvt_pk_bf16(s[6 * 33], s[7 * 33]);
            *(v4u*)(d.WT + (size_t)map_col(d.mapid, n0 + n) * d.K + k0 + 8 * c) = o; } }
    asm volatile("s_waitcnt lgkmcnt(0)" ::: "memory");
}

__global__ void __launch_bounds__(512) fwd_megakernel(Args args) {
    extern __shared__ __attribute__((aligned(16))) unsigned char lds[];
    LAS unsigned char* ldsL = (LAS unsigned char*)lds;
    const int tid = threadIdx.x, lane = tid & 63, wave = __builtin_amdgcn_readfirstlane(tid >> 6);
    const int G = gridDim.x, bx = blockIdx.x;
    const int vcu = (G % 8 == 0) ? (bx % 8) * (G / 8) + bx / 8 : bx;
    unsigned char* ws = args.ws;
    const float* x = args.in[0];
    float* out = args.out;
    float* SQ = (float*)(ws + WS_SQ); float* SKV = (float*)(ws + WS_SKV); float* SH1 = (float*)(ws + WS_SH1); float* SH2 = (float*)(ws + WS_SH2); float* ROPE = (float*)(ws + WS_ROPE);
    bf16b* Win_t = (bf16b*)(ws + WS_WIN); bf16b* Wuq_t = (bf16b*)(ws + WS_WUQ); bf16b* Wukv_t = (bf16b*)(ws + WS_WUKV); bf16b* Wm_t = (bf16b*)(ws + WS_WM);
    bf16b* Wf_t = (bf16b*)(ws + WS_WF); bf16b* Wout_t = (bf16b*)(ws + WS_WOUT); bf16b* Wup_t = (bf16b*)(ws + WS_WUP); bf16b* Wdown_t = (bf16b*)(ws + WS_WDOWN);
    bf16b* XN = (bf16b*)(ws + WS_XN); bf16b* QM = XN; bf16b* MIX = XN;
    bf16b* CQ = (bf16b*)(ws + WS_CQ); bf16b* CKV = (bf16b*)(ws + WS_CKV); bf16b* KR = (bf16b*)(ws + WS_KR); float* FF = (float*)(ws + WS_FF); float* BIASK = (float*)(ws + WS_BIAS);
    bf16b* FQ = (bf16b*)(ws + WS_FQ); bf16b* H1B = FQ; bf16b* GATES = (bf16b*)(ws + WS_GATES);
    bf16b* KN = (bf16b*)(ws + WS_KN); bf16b* VM = (bf16b*)(ws + WS_VM); bf16b* OM = (bf16b*)(ws + WS_OM); bf16b* OF = (bf16b*)(ws + WS_OF); bf16b* U = (bf16b*)(ws + WS_U);
    const int lo = args.ph_lo, hi = args.ph_hi;
    volatile LAS unsigned* bst = (volatile LAS unsigned*)(ldsL + 131072);
    XcdBarrier bar; bar.bar = (unsigned*)(ws + WS_BAR) + args.li * XCD_BAR_WORDS; bar.x = xb_xcc_id(); bar.st = bst;
    if (tid == 0) {
        const unsigned lr_ = xb_add(&bar.bar[XB_XCNT(bar.x)], 1u);
        unsigned sum, cnt, mine, xi_, sp = 0u;
        for (;;) { sum = 0u; cnt = 0u; mine = 0u; xi_ = 0u;
#pragma unroll
            for (unsigned j = 0; j < 16; ++j) { const unsigned c = xb_ld(&bar.bar[XB_XCNT(j)]); sum += c; if (j == bar.x) { mine = c; xi_ = cnt; } cnt += (c > 0u) ? 1u : 0u; }
            if (sum == (unsigned)G) break;
            __builtin_amdgcn_s_sleep(1);
            if (++sp > (1u << 22)) break; }
        bst[0] = mine > 0u ? mine : 1u; bst[1] = cnt > 0u ? cnt : 1u; bst[4] = xi_; bst[5] = lr_;
    }
    __syncthreads();
    Own own; own.nloc = (int)bst[0]; own.nx = (int)bst[1]; own.xi = (int)bst[4]; own.lr = (int)bst[5];
    own.nloc = __builtin_amdgcn_readfirstlane(own.nloc); own.nx = __builtin_amdgcn_readfirstlane(own.nx); own.xi = __builtin_amdgcn_readfirstlane(own.xi); own.lr = __builtin_amdgcn_readfirstlane(own.lr);
    if (args.ph_lo < 0) cg::this_grid().sync();
#ifndef PHMASK
#define PHMASK 0x1ff
#endif
#define IN(k) (((PHMASK >> (k)) & 1) && lo <= (k) && (k) < hi)
#ifndef REPMASK
#define REPMASK 0
#endif
#define REP(k) (((REPMASK >> (k)) & 1) ? 2 : 1)
#define SEAM(k) do { if (IN(k) && IN((k) + 1)) xcd_barrier(bar); } while (0)
    pg8::Epi E{}; E.CQ = CQ; E.CKV = CKV; E.KR = KR; E.FQKV = FQ; E.GATES = GATES; E.QM = QM; E.KN = KN; E.VM = VM; E.MIX = MIX; E.TMP = FQ; E.H1B = H1B; E.U = U;
    E.GN = args.in[14]; E.PCNT = (unsigned*)(ws + WS_PCNT); E.fuse8 = (!MK_MULTI && CUT_MASK == 0 && XGM == 4 && own.nloc == 32) ? 1 : 0;
    E.FF = FF; E.SQ = SQ; E.SKV = SKV; E.SH1 = SH1; E.SH2 = SH2; E.OUT = out; E.X = x; E.ROPE = ROPE;

    if (IN(0)) for (int rp_ = 0; rp_ < REP(0); ++rp_) {
        const int gw = bx * 8 + wave, NGW = G * 8;
        LAS float* scr = (LAS float*)(ldsL + wave * 16384);
        constexpr int I_IN = 32 * 251, I_UQ = 8 * 48, I_UKV = 4 * 64, I_BR = 16 * 64, I_OUT = 32 * 64, I_UP = 32 * 256, I_DN = 128 * 64;
        constexpr int NITEMS = I_IN + I_UQ + I_UKV + 2 * I_BR + I_OUT + I_UP + I_DN;
#define P0_DECODE(D, it_) do { int r = (it_); \
            if (r < I_IN) { (D) = TDesc{args.in[2], args.in[1], Win_t, 2048, DIN, 1, r}; } else { r -= I_IN; \
            if (r < I_UQ) { (D) = TDesc{args.in[5], args.in[4], Wuq_t, 512, 1536, 2, r}; } else { r -= I_UQ; \
            if (r < I_UKV) { (D) = TDesc{args.in[7], args.in[6], Wukv_t, 256, 2048, 3, r}; } else { r -= I_UKV; \
            if (r < I_BR) { (D) = TDesc{args.in[8], nullptr, Wm_t, 1024, 2048, 0, r}; } else { r -= I_BR; \
            if (r < I_BR) { (D) = TDesc{args.in[9], nullptr, Wf_t, 1024, 2048, 0, r}; } else { r -= I_BR; \
            if (r < I_OUT) { (D) = TDesc{args.in[10], nullptr, Wout_t, 2048, 2048, 0, r}; } else { r -= I_OUT; \
            if (r < I_UP) { (D) = TDesc{args.in[12], args.in[11], Wup_t, 2048, 8192, 0, r}; } else { r -= I_UP; \
            (D) = TDesc{args.in[13], nullptr, Wdown_t, 8192, 2048, 0, r}; } } } } } } } } while (0)
        if (gw < NITEMS) {
            int it = gw; TDesc dc; P0_DECODE(dc, it); f32x4 vc[8]; float gc[8]; p0_item_load(dc, lane, vc, gc);
            for (;;) { const int itn = it + NGW; const bool has = itn < NITEMS; TDesc dn = dc; f32x4 vn[8]; float gn[8];
                if (has) { P0_DECODE(dn, itn); p0_item_load(dn, lane, vn, gn); }
                p0_item_store(dc, lane, vc, gc, scr);
                if (!has) break;
#pragma unroll
                for (int i = 0; i < 8; ++i) { vc[i] = vn[i]; gc[i] = gn[i]; }
                dc = dn; it = itn; }
        }
#undef P0_DECODE
        Own ownr = own; if (!OWN_ROWS) { ownr.nx = 8; ownr.nloc = G / 8; ownr.xi = bx % 8; ownr.lr = bx / 8; }
        const int npan0 = own_npan(ownr, MROWS / 256), xend = npan0 * 256, xstep = ownr.nloc * 8;
        { int idx = ownr.lr * 8 + wave;
          if (idx < xend) { f32x4 v[8]; int m = own_panel(ownr, idx >> 8) * 256 + (idx & 255);
#pragma unroll
            for (int j = 0; j < 8; ++j) v[j] = ((const f32x4*)(x + (size_t)m * DMODEL) + lane)[64 * j];
            for (;;) { const int idn = idx + xstep; const bool has = idn < xend; f32x4 w[8]; int mn = m;
                if (has) { mn = own_panel(ownr, idn >> 8) * 256 + (idn & 255);
#pragma unroll
                    for (int j = 0; j < 8; ++j) w[j] = ((const f32x4*)(x + (size_t)mn * DMODEL) + lane)[64 * j]; }
                float s = 0.f;
#pragma unroll
                for (int j = 0; j < 8; ++j) s += (v[j].x * v[j].x + v[j].y * v[j].y) + (v[j].z * v[j].z + v[j].w * v[j].w);
                const float rs = rsqrtf(wave_sum(s) * (1.f / DMODEL) + EPS);
                unsigned long long* o8 = (unsigned long long*)(XN + (size_t)m * DMODEL) + lane;
#pragma unroll
                for (int j = 0; j < 8; ++j) o8[64 * j] = (unsigned long long)pg8::cvt_pk_bf16(v[j].x * rs, v[j].y * rs) | ((unsigned long long)pg8::cvt_pk_bf16(v[j].z * rs, v[j].w * rs) << 32);
                if (!has) break;
#pragma unroll
                for (int j = 0; j < 8; ++j) v[j] = w[j];
                idx = idn; m = mn; } } }
        const int gt = bx * 512 + tid, NGT = G * 512;
        for (int i = gt; i < SEQ * 32; i += NGT) { const int pos = i >> 5, k = i & 31;
            const float inv = 1.0f / powf(10000.0f, (float)k * (1.0f / 32.0f)); const float ang = (float)pos * inv;
            const double rev = (double)ang * 0.15915494309189535; const float fr = (float)(rev - __builtin_rint(rev));
            ROPE[2 * i] = __builtin_amdgcn_cosf(fr); ROPE[2 * i + 1] = __builtin_amdgcn_sinf(fr); }
    }
    SEAM(0);
    if (IN(1)) for (int rp_ = 0; rp_ < REP(1); ++rp_) { pg8::Gemm g{XN, Win_t, MROWS, NPROJ, 2048}; XOrder S; S.init(MROWS, NPROJ, own); E.mode = EM_PROJ;
        pg8::gemm_phase<pg8::Epi, XOrder, true, true>(ldsL, g, S, E); }
    SEAM(1);
    if (IN(2)) for (int rp_ = 0; rp_ < REP(2); ++rp_) {
        if (bx < 32) {
            const int b = bx >> 3, h = bx & 7; const float fb = args.in[3][h]; float v[16]; float run = 0.f;
#pragma unroll
            for (int i = 0; i < 16; ++i) { const float z = FF[((size_t)b * SEQ + tid * 16 + i) * 8 + h] + fb; const float ls = fminf(z, 0.f) - log1pf(expf(-fabsf(z))); run += ls; v[i] = run; }
            float incl = run;
#pragma unroll
            for (int o = 1; o < 64; o <<= 1) { const float t = __shfl_up(incl, o); if (lane >= o) incl += t; }
            LAS float* wt = (LAS float*)ldsL;
            if (lane == 63) wt[wave] = incl;
            __syncthreads();
            float base = incl - run;
            for (int w = 0; w < wave; ++w) base += wt[w];
            float* dst = BIASK + ((size_t)bx * SEQ + tid * 16);
#pragma unroll
            for (int i = 0; i < 16; ++i) dst[i] = -(base + v[i]) * 11.313708498984761f;
            __syncthreads();
        }
        { pg8::Gemm g{CQ, Wuq_t, MROWS, 1536, 512}; XOrder S; S.init(MROWS, 1536, own); E.mode = EM_QUP;
          pg8::gemm_phase<pg8::Epi, XOrder, true, true>(ldsL, g, S, E); }
        { pg8::Gemm g{CKV, Wukv_t, MROWS, 2048, 256}; XOrder S; S.init(MROWS, 2048, own); E.mode = EM_KVUP;
          pg8::gemm_phase<pg8::Epi, XOrder, true, true>(ldsL, g, S, E); }
    }
    SEAM(2);
    if (IN(3)) {
        using att::bf16; using att::BlockRef;
        Own owna = own; if (!OWN_ATT) { owna.nx = 8; owna.nloc = G / 8; owna.xi = bx % 8; owna.lr = bx / 8; }
        const int npanA = own_npan(owna, MROWS / 256); const bool fastdeal = (owna.nx == 8 && owna.nloc == 32 && npanA == 16);
#define MKREF(R, MODE_, e_) do { int pm_, h_; if (fastdeal && BATCH_MAP) { const int i_ = (e_) >> 6, which_ = ((e_) >> 5) & 1, l_ = (e_) & 31, p_ = l_ & 7, s_ = owna.xi & 1; h_ = 4 * i_ + (l_ >> 3); \
                pm_ = 32 * (owna.xi >> 1) + (which_ == 0 ? (s_ ? 23 - p_ : 31 - p_) : (s_ ? 8 + p_ : p_)); }     \
            else if (fastdeal) { const int j_ = (e_) & 31, i_ = (e_) >> 5; pm_ = own_panel(owna, (j_ >> 3) * 4 + i_); h_ = j_ & 7; } else { pm_ = own_panel(owna, (e_) >> 3); h_ = (e_) & 7; } \
            const int b_ = pm_ >> 5, qb_ = pm_ & 31, grp_ = b_ * 8 + h_; const size_t rb_ = (size_t)b_ * SEQ, rq_ = rb_ + (size_t)qb_ * 256; (R).P0 = qb_ * 256; \
            if ((MODE_) == 0) { (R).Q = (const bf16*)FQ + rq_ * 1024 + h_ * 128; (R).K = (const bf16*)FQ + (size_t)MROWS * 1024 + rb_ * 1024 + h_ * 128; (R).V = (const bf16*)FQ + (size_t)MROWS * 2048 + rb_ * 1024 + h_ * 128; \
                (R).O = (bf16*)OF + rq_ * 1024 + h_ * 128; (R).KR = nullptr; (R).BIAS = BIASK + (size_t)grp_ * SEQ; } \
            else { (R).Q = (const bf16*)QM + rq_ * 1536 + h_ * 192; (R).K = (const bf16*)KN + rb_ * 1024 + h_ * 128; (R).V = (const bf16*)VM + rb_ * 1024 + h_ * 128; \
                (R).O = (bf16*)OM + rq_ * 1024 + h_ * 128; (R).KR = (const bf16*)KR + rb_ * 64; (R).BIAS = nullptr; } } while (0)
#define STREAM(MODE_) do { for (int e = owna.lr; e < npanA * 8; e += owna.nloc) { BlockRef cur; MKREF(cur, MODE_, e); att::attn_block_np<MODE_>(cur, (char*)lds); } } while (0)
#if ATT_PIPE_FOX || ATT_PIPE_MLA
#define STREAMP(MODE_) do { int e = owna.lr; if (e < npanA * 8) { BlockRef cur, nxt; MKREF(cur, MODE_, e); att::Seam<MODE_> S; att::attn_prime<MODE_>(cur, (char*)lds, S); \
            for (;;) { const int en = e + owna.nloc; const bool last = en >= npanA * 8; if (last) nxt = cur; else MKREF(nxt, MODE_, en); \
                att::attn_block<MODE_>(cur, nxt, (char*)lds, S); if (last) break; cur = nxt; e = en; } } } while (0)
#endif
#ifndef ATT_REPEAT
#define ATT_REPEAT 1
#endif
        for (int rep = 0; rep < ATT_REPEAT; ++rep) {
#ifndef NO_FOX
#if ATT_PIPE_FOX
        STREAMP(0);
#else
        STREAM(0);
#endif
#endif
#ifndef NO_MLA
#if ATT_PIPE_MLA
        STREAMP(1);
#else
        STREAM(1);
#endif
#endif
        }
#undef STREAM
#undef MKREF
    }
    SEAM(3);
    if (IN(4)) for (int rp_ = 0; rp_ < REP(4); ++rp_) {
        { pg8::Gemm g{OM, Wm_t, MROWS, 2048, 1024}; XOrder S; S.init(MROWS, 2048, own); E.mode = EM_BR1;
          pg8::gemm_phase<pg8::Epi, XOrder, true, true>(ldsL, g, S, E); }
        { pg8::Gemm g{OF, Wf_t, MROWS, 2048, 1024}; XOrder S; S.init(MROWS, 2048, own); E.mode = EM_BR2;
          pg8::gemm_phase<pg8::Epi, XOrder, true, true>(ldsL, g, S, E); }
    }
    SEAM(4);
    if (IN(5)) for (int rp_ = 0; rp_ < REP(5); ++rp_) { pg8::Gemm g{MIX, Wout_t, MROWS, 2048, 2048}; XOrder S; S.init(MROWS, 2048, own); E.mode = EM_OUT;
        pg8::gemm_phase<pg8::Epi, XOrder, true, true>(ldsL, g, S, E); }
    SEAM(5);
    if (IN(6)) for (int rp_ = 0; rp_ < REP(6); ++rp_) { pg8::Gemm g{H1B, Wup_t, MROWS, DFF, 2048}; XOrder S; S.init(MROWS, DFF, own); E.mode = EM_UP;
        pg8::gemm_phase<pg8::Epi, XOrder, true, true>(ldsL, g, S, E); }
    SEAM(6);
    if (IN(7)) { pg8::Gemm g{U, Wdown_t, MROWS, 2048, DFF}; XOrder S; S.init(MROWS, 2048, own); E.mode = EM_DOWN;
        pg8::gemm_phase<pg8::Epi, XOrder, true, true>(ldsL, g, S, E); }
    SEAM(7);
    if (IN(8) && !E.fuse8) {
        const float* gn = args.in[14]; Own ownr = own; if (!OWN_ROWS) { ownr.nx = 8; ownr.nloc = G / 8; ownr.xi = bx % 8; ownr.lr = bx / 8; } const int npan8 = own_npan(ownr, MROWS / 256);
        f32x4 gv[8];
#pragma unroll
        for (int j = 0; j < 8; ++j) gv[j] = ((const f32x4*)gn)[lane + 64 * j];
        for (int idx = ownr.lr * 8 + wave; idx < npan8 * 256; idx += ownr.nloc * 8) { const int m = own_panel(ownr, idx >> 8) * 256 + (idx & 255); f32x4* orow = (f32x4*)(out + (size_t)m * DMODEL) + lane; float sq = lane < 32 ? SH2[(size_t)m * 32 + lane] : 0.f; sq = wave_sum(sq); const float rs = rsqrtf(sq * (1.f / DMODEL) + EPS);
#pragma unroll
            for (int j = 0; j < 8; ++j) { f32x4 v = orow[64 * j]; orow[64 * j] = v * rs * gv[j]; } }
    }
#undef IN
#undef SEAM
}

extern "C" void kernel_launch(void* const* d_in, const int* in_sizes, int n_in, void* d_out, int out_size, void* d_ws, size_t ws_size, hipStream_t stream) {
    static int grid = 0;
    if (grid == 0) {
        if (n_in != 15 || in_sizes[0] != MROWS * DMODEL || out_size != MROWS * DMODEL || ws_size < WS_END) {
            fprintf(stderr, "kernel_launch: unexpected shapes (n_in %d, in0 %d, out %d, ws %zu < %zu)\n", n_in, n_in > 0 ? in_sizes[0] : -1, out_size, ws_size, (size_t)WS_END); grid = -1; return; }
        int dev = 0, cus = 0, per_cu = 0;
        (void)hipGetDevice(&dev); (void)hipDeviceGetAttribute(&cus, hipDeviceAttributeMultiprocessorCount, dev);
        if (hipFuncSetAttribute((const void*)fwd_megakernel, hipFuncAttributeMaxDynamicSharedMemorySize, LDS_TOTAL) != hipSuccess) { fprintf(stderr, "kernel_launch: hipFuncSetAttribute failed\n"); grid = -1; return; }
        if (hipOccupancyMaxActiveBlocksPerMultiprocessor(&per_cu, (const void*)fwd_megakernel, 512, LDS_TOTAL) != hipSuccess || per_cu < 1) { fprintf(stderr, "kernel_launch: occupancy query says %d\n", per_cu); per_cu = 1; }
        (void)hipGetLastError();
        if (cus <= 0) cus = 256;
        grid = cus;
    }
    if (grid < 0) return;
    Args a{};
    for (int i = 0; i < 15; ++i) a.in[i] = (const float*)d_in[i];
    a.out = (float*)d_out; a.ws = (unsigned char*)d_ws;
    (void)hipMemsetAsync((unsigned char*)d_ws + WS_BAR, 0, 512 * 1024 + 128 * 256, stream);
    int li = 0;
    for (int p = 0; p < 9; ) { int q = p; while (q < 8 && !((CUT_MASK >> q) & 1)) ++q;
        a.ph_lo = p; a.ph_hi = q + 1; a.li = li++;
        void* kargs[] = {&a};
        hipError_t e = hipLaunchCooperativeKernel((const void*)fwd_megakernel, dim3(grid), dim3(512), kargs, LDS_TOTAL, stream);
        if (e != hipSuccess) fprintf(stderr, "kernel_launch: cooperative launch failed: %s (grid %d)\n", hipGetErrorString(e), grid);
        p = q + 1; }
}
```

```cpp
#include <hip/hip_runtime.h>
#include <hip/hip_bf16.h>
#include <hip/hip_cooperative_groups.h>
#include <cstdio>
#include <cstdint>
namespace cg = cooperative_groups;

#ifndef MK_MULTI
#define MK_MULTI 0
#endif

#ifndef OWN_GEMM
#define OWN_GEMM 1
#endif
#ifndef OWN_ATT
#define OWN_ATT 1
#endif
#ifndef OWN_ROWS
#define OWN_ROWS 1
#endif
constexpr int BATCH = 4, SEQ = 8192, DMODEL = 2048, MROWS = BATCH * SEQ, DIN = 8008, NPROJ = 8192, DFF = 8192;
constexpr float EPS = 1e-6f;
enum { EM_PROJ = 0, EM_QUP, EM_KVUP, EM_BR1, EM_BR2, EM_OUT, EM_UP, EM_DOWN };
namespace pg8 {
#define PG8_LAS __attribute__((address_space(3)))
typedef unsigned short bf16_t;
typedef short bf16x8 __attribute__((ext_vector_type(8)));
typedef float f32x4 __attribute__((ext_vector_type(4)));
typedef unsigned u32x4 __attribute__((ext_vector_type(4)));
constexpr int BM = 256, BK = 64, HALF = 128, HTB = HALF * BK * 2  , STAGE_BYTES = 8 * HTB, NXCD = 8, WGM = 8;

__host__ __device__ __forceinline__ int lds_byte(int r, int c) { const int st = (r >> 4) * 2 + (c >> 5), rr = r & 15, cc = c & 31, ob = rr * 64 + cc * 2; return st * 1024 + (ob ^ (((ob >> 9) & 1) << 5)); }
__host__ __device__ __forceinline__ void stage_rc(int b, int& R, int& C) { const int st = b / 1024, sb = b % 1024, swz = sb ^ (((sb >> 9) & 1) << 5); R = (st >> 1) * 16 + swz / 64; C = (st & 1) * 32 + (swz % 64) / 2; }
__host__ __device__ __forceinline__ int perm32(int rho) { const int n = rho >> 4, i = rho & 15; return 8 * (i >> 2) + 4 * n + (i & 3); }

struct Unit { int pm, pn; };
struct Gemm { const bf16_t* A; const bf16_t* Bt; int M, N, K; };

struct StaticOrder {
    int nM, nN, nwg, G, c;
    __host__ __device__ void init(int M, int N, int G_, int c_) { nM = M / BM; nN = N / BM; nwg = nM * nN; G = G_; c = c_; }
    __host__ __device__ bool next(int i, Unit& u) const {
        const long L = (long)i * G + c; if (L >= nwg) return false;
        int wgid = (int)L; { const int q = nwg / NXCD, r = nwg % NXCD, xcd = wgid % NXCD, off = wgid / NXCD; wgid = (xcd < r ? xcd * (q + 1) : r * (q + 1) + (xcd - r) * q) + off; }
        const int nig = WGM * nN, gid = wgid / nig, fm = gid * WGM, gsz = (nM - fm) < WGM ? (nM - fm) : WGM;
        u.pm = fm + ((wgid % nig) % gsz); u.pn = (wgid % nig) / gsz; return true;
    }
    __device__ __forceinline__ void a_ready(const Unit&) const {}
    __device__ __forceinline__ void done(const Unit&) const {}
};

typedef float f32x2c_t __attribute__((ext_vector_type(2))); typedef __bf16 bf16x2c_t __attribute__((ext_vector_type(2)));
__device__ __forceinline__ unsigned cvt_pk_bf16(float lo, float hi) { f32x2c_t v = {lo, hi}; bf16x2c_t b = __builtin_convertvector(v, bf16x2c_t); return __builtin_bit_cast(unsigned, b); }
typedef float f32x2 __attribute__((ext_vector_type(2)));
typedef unsigned u32x2 __attribute__((ext_vector_type(2)));
__device__ __forceinline__ u32x4 pack8(f32x4 a, f32x4 b) { u32x4 w; w.x = cvt_pk_bf16(a[0], a[1]); w.y = cvt_pk_bf16(a[2], a[3]); w.z = cvt_pk_bf16(b[0], b[1]); w.w = cvt_pk_bf16(b[2], b[3]); return w; }
__device__ __forceinline__ void unpack8(u32x4 w, f32x4& a, f32x4& b) {
    a[0] = __uint_as_float(w.x << 16); a[1] = __uint_as_float(w.x & 0xffff0000u); a[2] = __uint_as_float(w.y << 16); a[3] = __uint_as_float(w.y & 0xffff0000u);
    b[0] = __uint_as_float(w.z << 16); b[1] = __uint_as_float(w.z & 0xffff0000u); b[2] = __uint_as_float(w.w << 16); b[3] = __uint_as_float(w.w & 0xffff0000u); }
__device__ __forceinline__ void rope8(f32x4& a, f32x4& b, const float* tab) {
    const f32x4 t0 = *(const f32x4*)tab, t1 = *(const f32x4*)(tab + 4);
    float x1, x2;
    x1 = a[0]; x2 = a[1]; a[0] = x1 * t0[0] - x2 * t0[1]; a[1] = x1 * t0[1] + x2 * t0[0];
    x1 = a[2]; x2 = a[3]; a[2] = x1 * t0[2] - x2 * t0[3]; a[3] = x1 * t0[3] + x2 * t0[2];
    x1 = b[0]; x2 = b[1]; b[0] = x1 * t1[0] - x2 * t1[1]; b[1] = x1 * t1[1] + x2 * t1[0];
    x1 = b[2]; x2 = b[3]; b[2] = x1 * t1[2] - x2 * t1[3]; b[3] = x1 * t1[3] + x2 * t1[2];
}
__device__ __forceinline__ void rope8v(f32x4& a, f32x4& b, const f32x4 t0, const f32x4 t1) {
    float x1, x2;
    x1 = a[0]; x2 = a[1]; a[0] = x1 * t0[0] - x2 * t0[1]; a[1] = x1 * t0[1] + x2 * t0[0];
    x1 = a[2]; x2 = a[3]; a[2] = x1 * t0[2] - x2 * t0[3]; a[3] = x1 * t0[3] + x2 * t0[2];
    x1 = b[0]; x2 = b[1]; b[0] = x1 * t1[0] - x2 * t1[1]; b[1] = x1 * t1[1] + x2 * t1[0];
    x1 = b[2]; x2 = b[3]; b[2] = x1 * t1[2] - x2 * t1[3]; b[3] = x1 * t1[3] + x2 * t1[2];
}
__device__ __forceinline__ float sigm(float v) { return __builtin_amdgcn_rcpf(1.f + __expf(-v)); }
__device__ __forceinline__ float sumsq8(f32x4 a, f32x4 b) { return (a[0] * a[0] + a[1] * a[1]) + (a[2] * a[2] + a[3] * a[3]) + (b[0] * b[0] + b[1] * b[1]) + (b[2] * b[2] + b[3] * b[3]); }
__device__ __forceinline__ void ssq_commit(float* p, float s, int fq) { s += __shfl_xor(s, 16); s += __shfl_xor(s, 32); if (fq == 0) *p = s; }
template <int NS> __device__ __forceinline__ float ssq_sum(const float* p) { float s = 0.f;
#pragma unroll
    for (int i = 0; i < NS / 4; ++i) { const f32x4 v = *(const f32x4*)(p + 4 * i); s += (v[0] + v[1]) + (v[2] + v[3]); } return s; }

template <int NS> __device__ __forceinline__ float ssq_sum_sh(const float* p, int fq) {
    float s;
    if (NS == 32) { const f32x4 a = *(const f32x4*)(p + 8 * fq), b = *(const f32x4*)(p + 8 * fq + 4); s = ((a[0] + a[1]) + (a[2] + a[3])) + ((b[0] + b[1]) + (b[2] + b[3])); }
    else if (NS == 8) { s = p[2 * fq] + p[2 * fq + 1]; }
    else { s = p[fq]; }
    s += __shfl_xor(s, 16); s += __shfl_xor(s, 32); return s;
}
__device__ __forceinline__ size_t sh_base(int pm, int s, int wr, int fr) { return ((((size_t)pm * 32 + s) * 2 + wr) * 16 + fr) * 8; }
__device__ __forceinline__ void sh_commit8(float* SH, int pm, int s, int wr, int fr, int fq, float (&ss)[8]) {
#pragma unroll
    for (int k = 0; k < 8; ++k) { ss[k] += __shfl_xor(ss[k], 16); ss[k] += __shfl_xor(ss[k], 32); }
    if (fq == 0) { float* p = SH + sh_base(pm, s, wr, fr); *(f32x4*)p = (f32x4){ss[0], ss[1], ss[2], ss[3]}; *(f32x4*)(p + 4) = (f32x4){ss[4], ss[5], ss[6], ss[7]}; }
}
__device__ __forceinline__ void sh_sum8(const float* SH, int pm, int wr, int fr, int fq, float (&o8)[8]) {
    f32x4 a = {0.f, 0.f, 0.f, 0.f}, b = {0.f, 0.f, 0.f, 0.f};
#pragma unroll
    for (int j = 0; j < 8; ++j) { const float* p = SH + sh_base(pm, 8 * fq + j, wr, fr); a += *(const f32x4*)p; b += *(const f32x4*)(p + 4);
        if ((j & 1) == 1) asm volatile("" : "+v"(a), "+v"(b) :: "memory"); }
#pragma unroll
    for (int k = 0; k < 4; ++k) { o8[k] = a[k]; o8[4 + k] = b[k]; }
#pragma unroll
    for (int k = 0; k < 8; ++k) { o8[k] += __shfl_xor(o8[k], 16); o8[k] += __shfl_xor(o8[k], 32); }
}
struct Epi {
    static constexpr bool PERM = true, AFTER_DRAIN = false;
    int mode;
    bf16_t *CQ, *CKV, *KR, *FQKV, *GATES, *QM, *KN, *VM, *MIX, *TMP, *H1B, *U;
    float *FF, *SQ, *SKV, *SH1, *SH2, *OUT; const float* X; const float* ROPE; const float* GN; unsigned* PCNT; int fuse8;
    __device__ __forceinline__ void operator()(f32x4 (&acc)[2][2][4][2], const Unit& u, int wr, int wc, int fr, int fq) const {
        const int rowb = u.pm * BM + wr * 64 + fr, colb = u.pn * BM + wc * 32 + 8 * fq;
        constexpr size_t MR = (size_t)MROWS; (void)MR;
#define ROWOF(ai, m) ((size_t)(rowb + (ai) * HALF + (m) * 16))
        if (mode == EM_PROJ) {
            const int pn = u.pn;
#pragma unroll
            for (int ai = 0; ai < 2; ++ai)
#pragma unroll
                for (int m = 0; m < 4; ++m) { const size_t rw = ROWOF(ai, m); const int row = (int)rw;
                    if (pn < 3) { float ss = 0.f;
#pragma unroll
                        for (int bj = 0; bj < 2; ++bj) { const int col = colb + bj * HALF; const f32x4 v0 = acc[ai][bj][m][0], v1 = acc[ai][bj][m][1]; ss += sumsq8(v0, v1);
                            if (pn < 2) *(u32x4*)(CQ + rw * 512 + col) = pack8(v0, v1); else *(u32x4*)(CKV + rw * 256 + (col - 512)) = pack8(v0, v1); }
                        if (pn < 2) ssq_commit(SQ + rw * 8 + pn * 4 + wc, ss, fq); else ssq_commit(SKV + rw * 4 + wc, ss, fq);
                    } else if (pn == 3) {
                        const int lc = wc * 32 + 8 * fq;
                        if (lc < 64) { if (m == 0) {
                                f32x4 tb[4][2];
#pragma unroll
                                for (int mm = 0; mm < 4; ++mm) { const float* tp = ROPE + ((ROWOF(ai, mm) & (size_t)(SEQ - 1)) * 32 + (size_t)(lc >> 1)) * 2; tb[mm][0] = *(const f32x4*)tp; tb[mm][1] = *(const f32x4*)(tp + 4); }
#pragma unroll
                                for (int mm = 0; mm < 4; ++mm) { f32x4 v0 = acc[ai][0][mm][0], v1 = acc[ai][0][mm][1]; rope8v(v0, v1, tb[mm][0], tb[mm][1]); *(u32x4*)(KR + ROWOF(ai, mm) * 64 + lc) = pack8(v0, v1); } } }
                        else if (lc == 64) { *(f32x4*)(FF + rw * 8) = acc[ai][0][m][0]; *(f32x4*)(FF + rw * 8 + 4) = acc[ai][0][m][1]; }
                    } else if (pn < 16) {
                        const int t = (pn - 4) >> 2;
#pragma unroll
                        for (int bj = 0; bj < 2; ++bj) { const int col = colb + bj * HALF - 1024 - t * 1024; *(u32x4*)(FQKV + (size_t)t * MR * 1024 + rw * 1024 + col) = pack8(acc[ai][bj][m][0], acc[ai][bj][m][1]); }
                    } else {
#pragma unroll
                        for (int bj = 0; bj < 2; ++bj) { const int col = colb + bj * HALF - 4096; f32x4 v0 = acc[ai][bj][m][0], v1 = acc[ai][bj][m][1];
#pragma unroll
                            for (int i = 0; i < 4; ++i) { v0[i] = sigm(v0[i]); v1[i] = sigm(v1[i]); }
                            *(u32x4*)(GATES + rw * 4096 + col) = pack8(v0, v1); }
                    }
                }
        } else if (mode == EM_QUP || mode == EM_KVUP || mode == EM_UP) {
            float rsv[2][4];
            if (mode == EM_UP) { float t8[8]; sh_sum8(SH1, u.pm, wr, fr, fq, t8);
#pragma unroll
                for (int k = 0; k < 8; ++k) rsv[k >> 2][k & 3] = t8[k] * (1.f / 2048.f); }
            else {
#pragma unroll
                for (int ai = 0; ai < 2; ++ai)
#pragma unroll
                    for (int m = 0; m < 4; ++m) { const size_t rw = ROWOF(ai, m);
                        rsv[ai][m] = mode == EM_QUP ? ssq_sum_sh<8>(SQ + rw * 8, fq) * (1.f / 512.f) : ssq_sum_sh<4>(SKV + rw * 4, fq) * (1.f / 256.f); } }
#pragma unroll
            for (int ai = 0; ai < 2; ++ai)
#pragma unroll
                for (int m = 0; m < 4; ++m) rsv[ai][m] = rsqrtf(rsv[ai][m] + EPS);
            if (mode == EM_QUP) {
                const int g0 = (u.pn * 8 + wc) % 6, g1 = (u.pn * 8 + 4 + wc) % 6;
#pragma unroll
                for (int am = 0; am < 4; ++am) { const int ai = am >> 1, mb = (am & 1) * 2;
                    f32x4 tb[4][2][2];
#pragma unroll
                    for (int m = mb; m < mb + 2; ++m)
#pragma unroll
                        for (int bj = 0; bj < 2; ++bj) { const int g = bj ? g1 : g0;
                            if (g >= 4) { const float* tp = ROPE + ((ROWOF(ai, m) & (size_t)(SEQ - 1)) * 32 + (size_t)(((g - 4) * 32 + 8 * fq) >> 1)) * 2; tb[m][bj][0] = *(const f32x4*)tp; tb[m][bj][1] = *(const f32x4*)(tp + 4); } }
#pragma unroll
                    for (int m = mb; m < mb + 2; ++m) { const size_t rw = ROWOF(ai, m); const float rs = rsv[ai][m];
#pragma unroll
                        for (int bj = 0; bj < 2; ++bj) { const int col = colb + bj * HALF, g = bj ? g1 : g0; f32x4 v0 = acc[ai][bj][m][0] * rs, v1 = acc[ai][bj][m][1] * rs;
                            if (g >= 4) rope8v(v0, v1, tb[m][bj][0], tb[m][bj][1]);
                            *(u32x4*)(QM + rw * 1536 + col) = pack8(v0, v1); } }
                }
            } else if (mode == EM_KVUP) {
#pragma unroll
                for (int ai = 0; ai < 2; ++ai)
#pragma unroll
                    for (int m = 0; m < 4; ++m) { const size_t rw = ROWOF(ai, m); const float rs = rsv[ai][m];
#pragma unroll
                        for (int bj = 0; bj < 2; ++bj) { const int col = colb + bj * HALF; const f32x4 v0 = acc[ai][bj][m][0] * rs, v1 = acc[ai][bj][m][1] * rs;
                            if (u.pn < 4) *(u32x4*)(KN + rw * 1024 + col) = pack8(v0, v1); else *(u32x4*)(VM + rw * 1024 + (col - 1024)) = pack8(v0, v1); } }
            } else {
#pragma unroll
                for (int ai = 0; ai < 2; ++ai)
#pragma unroll
                    for (int m = 0; m < 4; ++m) { const size_t rw = ROWOF(ai, m); const float rs = rsv[ai][m];
#pragma unroll
                        for (int bj = 0; bj < 2; ++bj) { const int col = colb + bj * HALF; f32x4 v0 = acc[ai][bj][m][0], v1 = acc[ai][bj][m][1];
#pragma unroll
                            for (int i = 0; i < 4; ++i) { float a = fmaxf(v0[i], 0.f) * rs, b = fmaxf(v1[i], 0.f) * rs; v0[i] = a * a; v1[i] = b * b; }
                            *(u32x4*)(U + rw * 8192 + col) = pack8(v0, v1); } }
            }
        } else if (mode == EM_BR1) {
            u32x4 gt[2][4][2];
#pragma unroll
            for (int ai = 0; ai < 2; ++ai)
#pragma unroll
                for (int m = 0; m < 4; ++m)
#pragma unroll
                    for (int bj = 0; bj < 2; ++bj) gt[ai][m][bj] = *(const u32x4*)(GATES + ROWOF(ai, m) * 4096 + colb + bj * HALF);
#pragma unroll
            for (int ai = 0; ai < 2; ++ai)
#pragma unroll
                for (int m = 0; m < 4; ++m)
#pragma unroll
                    for (int bj = 0; bj < 2; ++bj) { f32x4 g0, g1; unpack8(gt[ai][m][bj], g0, g1);
                        *(u32x4*)(TMP + ROWOF(ai, m) * 2048 + colb + bj * HALF) = pack8(acc[ai][bj][m][0] * g0, acc[ai][bj][m][1] * g1); }
        } else if (mode == EM_BR2) {
#pragma unroll
            for (int ai = 0; ai < 2; ++ai) {
                u32x4 gt[4][2], tt[4][2];
#pragma unroll
                for (int m = 0; m < 4; ++m)
#pragma unroll
                    for (int bj = 0; bj < 2; ++bj) { gt[m][bj] = *(const u32x4*)(GATES + ROWOF(ai, m) * 4096 + 2048 + colb + bj * HALF); tt[m][bj] = *(const u32x4*)(TMP + ROWOF(ai, m) * 2048 + colb + bj * HALF); }
#pragma unroll
                for (int m = 0; m < 4; ++m)
#pragma unroll
                    for (int bj = 0; bj < 2; ++bj) { f32x4 g0, g1, t0, t1; unpack8(gt[m][bj], g0, g1); unpack8(tt[m][bj], t0, t1);
                        *(u32x4*)(MIX + ROWOF(ai, m) * 2048 + colb + bj * HALF) = pack8(t0 + acc[ai][bj][m][0] * g0, t1 + acc[ai][bj][m][1] * g1); }
            }
        } else if (mode == EM_DOWN && !fuse8) {
#pragma unroll
            for (int ai = 0; ai < 2; ++ai)
#pragma unroll
                for (int m = 0; m < 4; ++m) { const size_t rw = ROWOF(ai, m); float ss = 0.f;
#pragma unroll
                    for (int bj = 0; bj < 2; ++bj) { const size_t o = rw * 2048 + colb + bj * HALF; f32x4 r0, r1; unpack8(*(const u32x4*)(H1B + o), r0, r1); const f32x4 h0 = r0 + acc[ai][bj][m][0], h1 = r1 + acc[ai][bj][m][1];
                        *(f32x4*)(OUT + o) = h0; *(f32x4*)(OUT + o + 4) = h1; ss += sumsq8(h0, h1); }
                    ss += __shfl_xor(ss, 16); ss += __shfl_xor(ss, 32); if (fq == 0) SH2[sh_base(u.pm, u.pn * 4 + wc, wr, fr) + ai * 4 + m] = ss; }
        } else if (mode == EM_OUT) { float ss8[8];
            const float* RES = X;
#pragma unroll
            for (int ai = 0; ai < 2; ++ai) {
                f32x4 xin[4][2][2];
#pragma unroll
                for (int m = 0; m < 4; ++m)
#pragma unroll
                    for (int bj = 0; bj < 2; ++bj) { const size_t o = ROWOF(ai, m) * 2048 + colb + bj * HALF; xin[m][bj][0] = *(const f32x4*)(RES + o); xin[m][bj][1] = *(const f32x4*)(RES + o + 4); }
#pragma unroll
                for (int m = 0; m < 4; ++m) { const size_t rw = ROWOF(ai, m); float ss = 0.f;
#pragma unroll
                    for (int bj = 0; bj < 2; ++bj) { const size_t o = rw * 2048 + colb + bj * HALF; const f32x4 h0 = xin[m][bj][0] + acc[ai][bj][m][0], h1 = xin[m][bj][1] + acc[ai][bj][m][1];
                        *(u32x4*)(H1B + o) = pack8(h0, h1); ss += sumsq8(h0, h1); }
                    ss8[ai * 4 + m] = ss; }
            }
            sh_commit8(SH1, u.pm, u.pn * 4 + wc, wr, fr, fq, ss8);
        } else { float ss8[8];
#pragma unroll
            for (int am = 0; am < 4; ++am) { const int ai = am >> 1, mb = (am & 1) * 2;
                u32x4 xin[2][2];
#pragma unroll
                for (int m2 = 0; m2 < 2; ++m2)
#pragma unroll
                    for (int bj = 0; bj < 2; ++bj) xin[m2][bj] = *(const u32x4*)(H1B + ROWOF(ai, mb + m2) * 2048 + colb + bj * HALF);
#pragma unroll
                for (int m2 = 0; m2 < 2; ++m2) { const int m = mb + m2; float ss = 0.f;
#pragma unroll
                    for (int bj = 0; bj < 2; ++bj) { f32x4 r0, r1; unpack8(xin[m2][bj], r0, r1); acc[ai][bj][m][0] += r0; acc[ai][bj][m][1] += r1; ss += sumsq8(acc[ai][bj][m][0], acc[ai][bj][m][1]); }
                    ss8[ai * 4 + m] = ss; }
                asm volatile("" ::: "memory"); }
            sh_commit8(SH2, u.pm, u.pn * 4 + wc, wr, fr, fq, ss8);
            asm volatile("s_waitcnt vmcnt(0)" ::: "memory");
            unsigned* c = PCNT + 64 * u.pm;
            if (fr == 0 && fq == 0) __hip_atomic_fetch_add(c, 1u, __ATOMIC_RELAXED, __HIP_MEMORY_SCOPE_AGENT);
            { unsigned sp = 0u; while (__hip_atomic_load(c, __ATOMIC_RELAXED, __HIP_MEMORY_SCOPE_AGENT) < 64u) { __builtin_amdgcn_s_sleep(1); if (++sp > (1u << 24)) break; } }
            __builtin_amdgcn_fence(__ATOMIC_ACQUIRE, "agent"); asm volatile("s_waitcnt vmcnt(0)" ::: "memory");
            float t8[8]; sh_sum8(SH2, u.pm, wr, fr, fq, t8);
            f32x4 gv[2][2];
#pragma unroll
            for (int bj = 0; bj < 2; ++bj) { gv[bj][0] = *(const f32x4*)(GN + colb + bj * HALF); gv[bj][1] = *(const f32x4*)(GN + colb + bj * HALF + 4); }
#pragma unroll
            for (int ai = 0; ai < 2; ++ai)
#pragma unroll
                for (int m = 0; m < 4; ++m) { const size_t rw = ROWOF(ai, m); const float rs = rsqrtf(t8[ai * 4 + m] * (1.f / 2048.f) + EPS);
#pragma unroll
                    for (int bj = 0; bj < 2; ++bj) { const size_t o = rw * 2048 + colb + bj * HALF;
                        *(f32x4*)(OUT + o) = acc[ai][bj][m][0] * rs * gv[bj][0]; *(f32x4*)(OUT + o + 4) = acc[ai][bj][m][1] * rs * gv[bj][1]; } }
        }
#undef ROWOF
    }
};
template <class Epi, class Sched, bool ALIGN_EPI = false, bool SP2 = false>
__device__ __forceinline__ void gemm_phase(PG8_LAS unsigned char* lds, const Gemm g, const Sched& S, const Epi& E) {
    int tid_ = threadIdx.x; asm volatile("" : "+v"(tid_));
    const int tid = tid_, wid = __builtin_amdgcn_readfirstlane(tid >> 6), lane = tid & 63, wr = wid >> 2, wc = wid & 3, fr = lane & 15, fq = lane >> 4;
    const int K = g.K, nt = K / BK;
    unsigned voffA[2], voffB[2];
#pragma unroll
    for (int i = 0; i < 2; ++i) { int R, C; stage_rc(tid * 16 + i * 8192, R, C); const int Rb = Epi::PERM ? ((R & ~31) + perm32(R & 31)) : R;
        voffA[i] = (unsigned)(R * K + C) * 2u; voffB[i] = (unsigned)(Rb * K + C) * 2u; }
    const size_t kstep = (size_t)(BK * 2);
    const size_t hstep = (size_t)HALF * K * 2;
    const size_t tstep = 2 * hstep;
    const unsigned ldsw = (unsigned)wid * 1024u;
    const int aoff = lds_byte(wr * 64 + fr, fq * 8), boff = lds_byte(wc * 32 + fr, fq * 8);
#define PG8_SA(b, h) (((b) * 2 + (h)) * HTB)
#define PG8_SB(b, h) ((4 + (b) * 2 + (h)) * HTB)
#define PG8_STAGE(bufoff, gbase, voff) do { _Pragma("unroll") for (int _i = 0; _i < 2; ++_i) \
        __builtin_amdgcn_global_load_lds((const unsigned*)((const char*)(gbase) + (voff)[_i]), (PG8_LAS unsigned*)(lds + (bufoff) + ldsw + _i * 8192), 16, 0, 0); } while (0)
#define PG8_LDA(dst, b, h) do { _Pragma("unroll") for (int m = 0; m < 4; ++m) _Pragma("unroll") for (int k = 0; k < 2; ++k) dst[m][k] = *(const PG8_LAS bf16x8*)(lds + PG8_SA(b, h) + aoff + m * 2048 + k * 1024); } while (0)
#define PG8_LDB(dst, b, h) do { _Pragma("unroll") for (int n = 0; n < 2; ++n) _Pragma("unroll") for (int k = 0; k < 2; ++k) dst[n][k] = *(const PG8_LAS bf16x8*)(lds + PG8_SB(b, h) + boff + n * 2048 + k * 1024); } while (0)
#define PG8_MMA(ai, bj, At, Bt) do { __builtin_amdgcn_s_setprio(1); _Pragma("unroll") for (int m = 0; m < 4; ++m) _Pragma("unroll") for (int n = 0; n < 2; ++n) _Pragma("unroll") for (int k = 0; k < 2; ++k) \
        acc[ai][bj][m][n] = __builtin_amdgcn_mfma_f32_16x16x32_bf16(Bt[n][k], At[m][k], acc[ai][bj][m][n], 0, 0, 0); __builtin_amdgcn_s_setprio(0); } while (0)
#define PG8_WAIT_V(n) asm volatile("s_waitcnt vmcnt(" #n ")" ::: "memory")
#define PG8_WAIT_L(n) asm volatile("s_waitcnt lgkmcnt(" #n ")" ::: "memory")
#define PG8_BAR __builtin_amdgcn_s_barrier()
#define PG8_SCHED __builtin_amdgcn_sched_barrier(0)
    Unit cur, nxt; int ui = 0;
    if (!S.next(0, cur)) return;
    f32x4 acc[2][2][4][2];
#pragma unroll
    for (int a = 0; a < 2; ++a)
#pragma unroll
        for (int b = 0; b < 2; ++b)
#pragma unroll
            for (int m = 0; m < 4; ++m)
#pragma unroll
                for (int n = 0; n < 2; ++n) acc[a][b][m][n] = (f32x4){0.f, 0.f, 0.f, 0.f};
    bf16x8 At[4][2], B0[2][2], B1[2][2];
    const char* cA = (const char*)g.A + (size_t)cur.pm * tstep; const char* cB = (const char*)g.Bt + (size_t)cur.pn * tstep;
    S.a_ready(cur);
    if constexpr (SP2) {
        PG8_STAGE(PG8_SB(0, 0), cB, voffB); PG8_STAGE(PG8_SB(0, 1), cB + hstep, voffB); PG8_STAGE(PG8_SA(0, 0), cA, voffA); PG8_STAGE(PG8_SA(0, 1), cA + hstep, voffA);
        if (wr == 1) PG8_BAR;
        PG8_WAIT_V(2); PG8_BAR;
        PG8_STAGE(PG8_SB(1, 0), cB + kstep, voffB); PG8_STAGE(PG8_SA(1, 0), cA + kstep, voffA); PG8_STAGE(PG8_SB(1, 1), cB + hstep + kstep, voffB);
        PG8_WAIT_V(6); PG8_BAR;
    } else {
        PG8_STAGE(PG8_SB(0, 0), cB, voffB); PG8_STAGE(PG8_SA(0, 0), cA, voffA); PG8_STAGE(PG8_SB(0, 1), cB + hstep, voffB); PG8_STAGE(PG8_SA(0, 1), cA + hstep, voffA);
        if (wr == 1) PG8_BAR;
        PG8_WAIT_V(4); PG8_BAR;
        PG8_STAGE(PG8_SB(1, 0), cB + kstep, voffB); PG8_STAGE(PG8_SA(1, 0), cA + kstep, voffA); PG8_STAGE(PG8_SB(1, 1), cB + hstep + kstep, voffB);
        PG8_WAIT_V(6); PG8_BAR;
    }
    for (;;) {
        const bool has_next = S.next(ui + 1, nxt);
        const char* nA = has_next ? (const char*)g.A + (size_t)nxt.pm * tstep : cA; const char* nB = has_next ? (const char*)g.Bt + (size_t)nxt.pn * tstep : cB;
        for (int t = 0; t < nt; t += 2) {
            const bool last = (t == nt - 2);
            const char* a1 = cA + (size_t)(t + 1) * kstep;
            const char* a2 = last ? nA : cA + (size_t)(t + 2) * kstep; const char* b2 = last ? nB : cB + (size_t)(t + 2) * kstep;
            const char* a3 = a2 + kstep; const char* b3 = b2 + kstep;
            if (last && has_next) S.a_ready(nxt);
            if constexpr (SP2) {
            PG8_LDB(B0, 0, 0); PG8_LDB(B1, 0, 1); PG8_SCHED; PG8_LDA(At, 0, 0); PG8_STAGE(PG8_SA(1, 1), a1 + hstep, voffA);
            PG8_WAIT_V(8); PG8_WAIT_L(0); PG8_BAR; PG8_MMA(0, 0, At, B0); PG8_MMA(0, 1, At, B1); PG8_BAR; PG8_SCHED;
            PG8_LDA(At, 0, 1); PG8_STAGE(PG8_SB(0, 0), b2, voffB); PG8_STAGE(PG8_SB(0, 1), b2 + hstep, voffB); PG8_STAGE(PG8_SA(0, 0), a2, voffA);
            PG8_WAIT_V(8); PG8_WAIT_L(0); PG8_BAR; PG8_MMA(1, 0, At, B0); PG8_MMA(1, 1, At, B1); PG8_BAR; PG8_SCHED;
            PG8_LDB(B0, 1, 0); PG8_LDB(B1, 1, 1); PG8_SCHED; PG8_LDA(At, 1, 0); PG8_STAGE(PG8_SA(0, 1), a2 + hstep, voffA);
            PG8_WAIT_V(8); PG8_WAIT_L(0); PG8_BAR; PG8_MMA(0, 0, At, B0); PG8_MMA(0, 1, At, B1); PG8_BAR; PG8_SCHED;
            PG8_LDA(At, 1, 1); PG8_STAGE(PG8_SB(1, 0), b3, voffB); PG8_STAGE(PG8_SB(1, 1), b3 + hstep, voffB); PG8_STAGE(PG8_SA(1, 0), a3, voffA);
            PG8_WAIT_V(8); PG8_WAIT_L(0); PG8_BAR; PG8_MMA(1, 0, At, B0); PG8_MMA(1, 1, At, B1); PG8_BAR; PG8_SCHED;
            } else {
            PG8_LDB(B0, 0, 0); PG8_SCHED; PG8_LDA(At, 0, 0); PG8_STAGE(PG8_SA(1, 1), a1 + hstep, voffA);
            PG8_WAIT_L(8); PG8_BAR; PG8_WAIT_L(0); PG8_MMA(0, 0, At, B0); PG8_BAR; PG8_SCHED;
            PG8_LDB(B1, 0, 1); PG8_STAGE(PG8_SB(0, 0), b2, voffB);
            PG8_BAR; PG8_WAIT_L(0); PG8_MMA(0, 1, At, B1); PG8_BAR;
            PG8_LDA(At, 0, 1); PG8_STAGE(PG8_SA(0, 0), a2, voffA);
            PG8_BAR; PG8_WAIT_L(0); PG8_MMA(1, 0, At, B0); PG8_BAR; PG8_SCHED;
            PG8_STAGE(PG8_SB(0, 1), b2 + hstep, voffB);
            PG8_WAIT_V(6); PG8_BAR; PG8_MMA(1, 1, At, B1); PG8_BAR;
            PG8_LDB(B0, 1, 0); PG8_SCHED; PG8_LDA(At, 1, 0); PG8_STAGE(PG8_SA(0, 1), a2 + hstep, voffA);
            PG8_WAIT_L(8); PG8_BAR; PG8_WAIT_L(0); PG8_MMA(0, 0, At, B0); PG8_BAR; PG8_SCHED;
            PG8_LDB(B1, 1, 1); PG8_STAGE(PG8_SB(1, 0), b3, voffB);
            PG8_BAR; PG8_WAIT_L(0); PG8_MMA(0, 1, At, B1); PG8_BAR;
            PG8_LDA(At, 1, 1); PG8_STAGE(PG8_SA(1, 0), a3, voffA);
            PG8_BAR; PG8_WAIT_L(0); PG8_MMA(1, 0, At, B0); PG8_BAR; PG8_SCHED;
            PG8_STAGE(PG8_SB(1, 1), b3 + hstep, voffB);
            PG8_WAIT_V(6); PG8_BAR; PG8_MMA(1, 1, At, B1); PG8_BAR;
            }
        }
        if constexpr (ALIGN_EPI) { if (wr == 0) PG8_BAR; }
        if constexpr (!Epi::AFTER_DRAIN) { E(acc, cur, wr, wc, fr, fq); S.done(cur); }
        if (!has_next) break;
#pragma unroll
        for (int a = 0; a < 2; ++a)
#pragma unroll
            for (int b = 0; b < 2; ++b)
#pragma unroll
                for (int m = 0; m < 4; ++m)
#pragma unroll
                    for (int n = 0; n < 2; ++n) acc[a][b][m][n] = (f32x4){0.f, 0.f, 0.f, 0.f};
        cur = nxt; cA = nA; cB = nB; ++ui;
        if constexpr (ALIGN_EPI) { if (wr == 1) PG8_BAR; }
    }
    PG8_WAIT_V(0);
    if constexpr (!ALIGN_EPI) { if (wr == 0) PG8_BAR; }
    PG8_BAR;
    if constexpr (Epi::AFTER_DRAIN) { E.fused(acc, cur, wr, wc, fr, fq, lds, wid, lane); S.done(cur); }
#undef PG8_SA
#undef PG8_SB
#undef PG8_STAGE
#undef PG8_LDA
#undef PG8_LDB
#undef PG8_MMA
#undef PG8_WAIT_V
#undef PG8_WAIT_L
#undef PG8_BAR
#undef PG8_SCHED
}
}
#ifndef ATT_PIPE_FOX
#define ATT_PIPE_FOX 0
#endif
#ifndef ATT_PIPE_MLA
#define ATT_PIPE_MLA 0
#endif
namespace att {
using bf16 = __hip_bfloat16;
typedef short bf16x8 __attribute__((ext_vector_type(8)));
typedef short s16x4 __attribute__((ext_vector_type(4)));
typedef float f32x16 __attribute__((ext_vector_type(16)));
typedef float f32x4 __attribute__((ext_vector_type(4)));
typedef unsigned u32x4 __attribute__((ext_vector_type(4)));
constexpr int D = 128, NW = 8, QBLK = 32, KVBLK = 64, QB = NW * QBLK, LDKV = 1024, LDO = 1024;
constexpr int SHM_V = KVBLK * D * 2, SHM_K = KVBLK * D * 2, SHM_KR = KVBLK * 64 * 2;
constexpr int OFF_V = 0, OFF_K = 2 * SHM_V, OFF_KR = OFF_K + 2 * SHM_K, OFF_WS = OFF_KR + 2 * SHM_KR, OFF_BIAS = OFF_WS + NW * 64 * 4, LDS_BYTES = OFF_BIAS + 2 * 64 * 4;
constexpr float THR = 8.f;
template <int MODE> struct Cfg { static constexpr float SCALE = MODE ? 0.07216878364870322f : 0.08838834764831845f; static constexpr int QLD = MODE ? 1536 : 1024, NQ = MODE ? 12 : 8; };

#define KSWZ(row, colB) ((row) * 256 + ((colB) ^ (((row) & 7) << 4)))
#define SBAR() __builtin_amdgcn_sched_barrier(0)
__device__ __forceinline__ int v_st(int k, int c) { const int kk = (k & ~0xC) | ((k & 4) << 1) | ((k & 8) >> 1); return ((kk >> 3) * 4 + (c >> 5)) * 512 + ((kk & 7) * 32 + (c & 31)) * 2; }
__device__ __forceinline__ int v_rd_base(int lane) { return ((lane & 3) << 3) | (((lane >> 2) & 3) << 6) | (((lane >> 4) & 1) << 5) | (((lane >> 5) & 1) << 8); }
constexpr int v_rd_off(int d0, int ks, int half) { return d0 * 512 + ks * 4096 + half * 2048; }
__device__ __forceinline__ int crow(int r, int hi) { return (r & 3) + 8 * (r >> 2) + 4 * hi; }
__device__ __forceinline__ unsigned cvtpk(float lo, float hi) { unsigned r; asm volatile("v_cvt_pk_bf16_f32 %0, %1, %2" : "=v"(r) : "v"(lo), "v"(hi)); return r; }
__device__ __forceinline__ bf16x8 ld8(const bf16* p) { return *reinterpret_cast<const bf16x8*>(p); }
__device__ __forceinline__ void mask_tile(f32x16& p0, f32x16& p1, int dq) {
    const float NEG = -__builtin_inff();
#pragma unroll
    for (int r = 0; r < 16; ++r) { const int c = (r & 3) + 8 * (r >> 2); if (dq - c < 0) p0[r] = NEG; if (dq - c - 32 < 0) p1[r] = NEG; }
}
template <int MODE>
__device__ __forceinline__ void partialSM(f32x16& p0, f32x16& p1, float& m_reg, float& mn, float& alpha) {
    constexpr float SCALE = Cfg<MODE>::SCALE;
    float pmax = p0[0]; for (int r = 1; r < 16; ++r) pmax = fmaxf(pmax, p0[r]); for (int r = 0; r < 16; ++r) pmax = fmaxf(pmax, p1[r]);
    { auto rr = __builtin_amdgcn_permlane32_swap(__float_as_uint(pmax), __float_as_uint(pmax), false, false);
      pmax = fmaxf(__uint_as_float(rr[0]), __uint_as_float(rr[1])); }
    constexpr float C2 = 1.4426950408889634f * SCALE;
    if (__builtin_expect(__all((pmax - m_reg) * SCALE <= THR), 1)) { mn = m_reg; alpha = 1.f; }
    else { mn = fmaxf(m_reg, pmax); alpha = __builtin_amdgcn_exp2f((m_reg - mn) * C2); m_reg = mn; }
    const float mnL = -mn * C2;
    for (int r = 0; r < 16; ++r) p0[r] = fmaf(p0[r], C2, mnL); for (int r = 0; r < 16; ++r) p1[r] = fmaf(p1[r], C2, mnL);
    for (int r = 0; r < 16; ++r) p0[r] = __builtin_amdgcn_exp2f(p0[r]);
}
__device__ __forceinline__ void finishSM(f32x16& p0, f32x16& p1, float alpha, float& l_reg, bf16x8& pa0, bf16x8& pa1, bf16x8& pa2, bf16x8& pa3) {
    for (int r = 0; r < 16; ++r) p1[r] = __builtin_amdgcn_exp2f(p1[r]);
    float ps = 0; for (int r = 0; r < 16; ++r) ps += p0[r]; for (int r = 0; r < 16; ++r) ps += p1[r];
    { auto rr = __builtin_amdgcn_permlane32_swap(__float_as_uint(ps), __float_as_uint(ps), false, false);
      ps = __uint_as_float(rr[0]) + __uint_as_float(rr[1]); }
    l_reg = l_reg * alpha + ps;
#define PK4(P, B_, OUT) do { unsigned a0 = cvtpk(P[B_+0], P[B_+1]), a1 = cvtpk(P[B_+2], P[B_+3]);                          \
        unsigned b0 = cvtpk(P[B_+4], P[B_+5]), b1 = cvtpk(P[B_+6], P[B_+7]);                                             \
        auto r0 = __builtin_amdgcn_permlane32_swap(a0, b0, false, false); auto r1 = __builtin_amdgcn_permlane32_swap(a1, b1, false, false); \
        u32x4 w = {r0[0], r1[0], r0[1], r1[1]}; OUT = *reinterpret_cast<bf16x8*>(&w); } while (0)
    PK4(p0, 0, pa0); PK4(p0, 8, pa1); PK4(p1, 0, pa2); PK4(p1, 8, pa3);
#undef PK4
}
template <int KB, int MODE>
__device__ __forceinline__ void qkt(f32x16& p0, f32x16& p1, const char* lds, int r32, int hi, const bf16x8* qr, bool act) {
    if (MODE == 1 && !act) { const float NEG = -__builtin_inff();
#pragma unroll
        for (int r = 0; r < 16; ++r) { p0[r] = NEG; p1[r] = NEG; } return; }
    if (MODE == 0) { const float* bp = (const float*)(lds + OFF_BIAS) + KB * 64 + 4 * hi;
#pragma unroll
        for (int g = 0; g < 4; ++g) { const f32x4 a = *(const f32x4*)(bp + 8 * g), b = *(const f32x4*)(bp + 32 + 8 * g);
#pragma unroll
            for (int i = 0; i < 4; ++i) { p0[4 * g + i] = a[i]; p1[4 * g + i] = b[i]; } }
    } else { p0 = f32x16{}; p1 = f32x16{}; }
    int ko[4];
#pragma unroll
    for (int dd = 0; dd < 4; ++dd) ko[dd] = KSWZ(r32, (dd * 16 + hi * 8) * 2);
#pragma unroll
    for (int d0 = 0; d0 < 8; ++d0) { const char* a = lds + OFF_K + KB * SHM_K + ko[d0 & 3] + (d0 >> 2) * 128;
        bf16x8 b0 = *reinterpret_cast<const bf16x8*>(a);
        bf16x8 b1 = *reinterpret_cast<const bf16x8*>(a + 32 * 256);
        p0 = __builtin_amdgcn_mfma_f32_32x32x16_bf16(b0, qr[d0], p0, 0, 0, 0);
        p1 = __builtin_amdgcn_mfma_f32_32x32x16_bf16(b1, qr[d0], p1, 0, 0, 0);
        if ((d0 & 3) == 3) SBAR(); }
    if (MODE == 1) {
#pragma unroll
        for (int d0 = 0; d0 < 4; ++d0) { const char* a = lds + OFF_KR + KB * SHM_KR + ko[d0];
            bf16x8 b0 = *reinterpret_cast<const bf16x8*>(a);
            bf16x8 b1 = *reinterpret_cast<const bf16x8*>(a + 128);
            p0 = __builtin_amdgcn_mfma_f32_32x32x16_bf16(b0, qr[8 + d0], p0, 0, 0, 0);
            p1 = __builtin_amdgcn_mfma_f32_32x32x16_bf16(b1, qr[8 + d0], p1, 0, 0, 0); }
    }
}
template <int VB, bool SK>
__device__ __forceinline__ void pv_tile(f32x16* o, int vb0, bf16x8 pa0, bf16x8 pa1, bf16x8 pa2, bf16x8 pa3, bool act) {
    if (SK && !act) return;
#define TRRD(dst, off) asm volatile("ds_read_b64_tr_b16 %0, %1 offset:%2" : "=&v"(dst) : "v"(vb0), "i"(off) : "memory")
#define PV_D0(d0) do { s16x4 l0, l1, l2, l3, h0, h1, h2, h3; constexpr int b_ = VB * SHM_V + v_rd_off(d0, 0, 0); \
        TRRD(l0, b_); TRRD(h0, b_ + 2048); TRRD(l1, b_ + 4096); TRRD(h1, b_ + 6144); TRRD(l2, b_ + 8192); TRRD(h2, b_ + 10240); TRRD(l3, b_ + 12288); TRRD(h3, b_ + 14336); \
          \
        asm volatile("s_waitcnt lgkmcnt(6)" ::: "memory"); SBAR();   \
        o[d0] = __builtin_amdgcn_mfma_f32_32x32x16_bf16(pa0, (bf16x8){l0[0], l0[1], l0[2], l0[3], h0[0], h0[1], h0[2], h0[3]}, o[d0], 0, 0, 0); SBAR();  \
        asm volatile("s_waitcnt lgkmcnt(4)" ::: "memory"); SBAR();   \
        o[d0] = __builtin_amdgcn_mfma_f32_32x32x16_bf16(pa1, (bf16x8){l1[0], l1[1], l1[2], l1[3], h1[0], h1[1], h1[2], h1[3]}, o[d0], 0, 0, 0); SBAR();  \
        asm volatile("s_waitcnt lgkmcnt(2)" ::: "memory"); SBAR();   \
        o[d0] = __builtin_amdgcn_mfma_f32_32x32x16_bf16(pa2, (bf16x8){l2[0], l2[1], l2[2], l2[3], h2[0], h2[1], h2[2], h2[3]}, o[d0], 0, 0, 0); SBAR();  \
        asm volatile("s_waitcnt lgkmcnt(0)" ::: "memory"); SBAR();   \
        o[d0] = __builtin_amdgcn_mfma_f32_32x32x16_bf16(pa3, (bf16x8){l3[0], l3[1], l3[2], l3[3], h3[0], h3[1], h3[2], h3[3]}, o[d0], 0, 0, 0); } while (0)
    PV_D0(0); PV_D0(1); PV_D0(2); PV_D0(3);
#undef PV_D0
#undef TRRD
}

struct BlockRef { const bf16* Q; const bf16* K; const bf16* V; bf16* O; const bf16* KR; const float* BIAS; int P0; };
template <int MODE> struct Seam { bf16x8 qr[Cfg<MODE>::NQ]; bf16x8 st_v0, st_v1, st_k0, st_k1, st_kr; float st_b; };

#define ROWKV(p, k0, rr) ((p) + (size_t)((k0) + (rr)) * LDKV + sc)
#define VMW() asm volatile("s_waitcnt vmcnt(0)" ::: "memory")
#define VMWN(n) asm volatile("s_waitcnt vmcnt(%0)" :: "i"(n) : "memory")
#define SLOAD(R, k0) do { S.st_v0 = ld8(ROWKV((R).V, k0, sr)); S.st_v1 = ld8(ROWKV((R).V, k0, 32 + sr));              \
                          S.st_k0 = ld8(ROWKV((R).K, k0, sr)); S.st_k1 = ld8(ROWKV((R).K, k0, 32 + sr));              \
                          if (MODE == 1) S.st_kr = ld8((R).KR + (size_t)((k0) + (tid >> 3)) * 64 + (tid & 7) * 8);       \
                          if (MODE == 0) { if (tid < 64) S.st_b = (R).BIAS[(k0) + tid]; } } while (0)
#define SWRITE_K(bf) do { *(bf16x8*)(lds + OFF_K + (bf) * SHM_K + kws) = S.st_k0; *(bf16x8*)(lds + OFF_K + (bf) * SHM_K + kws + 32 * 256) = S.st_k1; \
                          if (MODE == 1) *(bf16x8*)(lds + OFF_KR + (bf) * SHM_KR + krws) = S.st_kr;                       \
                          if (MODE == 0) { if (tid < 64) ((float*)(lds + OFF_BIAS))[(bf) * 64 + tid] = S.st_b; } } while (0)
#define SWRITE_V(bf) do { *(bf16x8*)(lds + OFF_V + (bf) * SHM_V + vst0) = S.st_v0; *(bf16x8*)(lds + OFF_V + (bf) * SHM_V + vst1) = S.st_v1; } while (0)
#define SWRITE_KV(bf) do { SWRITE_V(bf); SWRITE_K(bf); } while (0)
#define QLOAD(R) do { _Pragma("unroll") for (int d0 = 0; d0 < 8; ++d0) S.qr[d0] = ld8((R).Q + (size_t)(wid * QBLK + r32) * Cfg<MODE>::QLD + d0 * 16 + hi * 8);   \
                      if (MODE == 1) { _Pragma("unroll") for (int d0 = 0; d0 < 4; ++d0) S.qr[(MODE ? 8 : 0) + d0] = ld8((R).Q + (size_t)(wid * QBLK + r32) * Cfg<MODE>::QLD + 128 + d0 * 16 + hi * 8); } } while (0)

template <int MODE>
__device__ __forceinline__ void attn_block_np(const BlockRef& cur, char* lds) {
    int tid_ = threadIdx.x; asm volatile("" : "+v"(tid_));
    const int tid = tid_, wid = __builtin_amdgcn_readfirstlane(tid >> 6), lane = tid & 63, r32 = lane & 31, hi = lane >> 5;
    const int NT = (cur.P0 + QB) / KVBLK;
    const int qlo = cur.P0 + wid * QBLK, qm = qlo + r32 - 4 * hi;
    float* ws = (float*)(lds + OFF_WS) + wid * 64; float* li_l = ws, * al_l = ws + 32;
    float m_reg = -1e30f, l_reg = 0; f32x16 o[4] = {};
    const int sr = tid >> 4, sc = (tid & 15) * 8, vst0 = v_st(sr, sc), vst1 = v_st(32 + sr, sc), kws = KSWZ(sr, sc * 2), krws = KSWZ((tid >> 3) & 31, ((tid >> 8) * 64 + (tid & 7) * 8) * 2);
    const int vb0 = (int)(uintptr_t)(lds + OFF_V) + v_rd_base(lane);
    Seam<MODE> S;
    QLOAD(cur);
    SLOAD(cur, 0); VMW(); SWRITE_KV(0);
    __syncthreads();
#define RESC(a) do { if (__any((a) < 1.f)) { if (hi == 0) al_l[r32] = (a); asm volatile("s_waitcnt lgkmcnt(0)" ::: "memory");              \
                     for (int d_ = 0; d_ < 4; ++d_) for (int r = 0; r < 16; ++r) o[d_][r] *= al_l[crow(r, hi)]; } } while (0)
#define KBASE(t) ((t) * KVBLK)
#define ACT(t) (MODE == 1 ? ((t) <= (qlo >> 6)) : (KBASE(t) <= qlo + QBLK - 1))
#define MASKT(P0_, P1_, t) do { if (MODE == 0) { const int kb_ = KBASE(t); if (kb_ + KVBLK - 1 > qlo) mask_tile(P0_, P1_, qm - kb_); } } while (0)
    f32x16 p0, p1; float mn, al; bf16x8 pa0, pa1, pa2, pa3;
#define STEP(t, KB) do {                                                                                                       \
        if ((t) + 1 < NT) { SLOAD(cur, KBASE((t) + 1)); }                                                                      \
        SBAR();                                                                                                                \
        if (ACT(t)) {                                                                                                          \
            qkt<KB, MODE>(p0, p1, lds, r32, hi, S.qr, true);                                                                   \
            MASKT(p0, p1, (t)); partialSM<MODE>(p0, p1, m_reg, mn, al); RESC(al);                                              \
            finishSM(p0, p1, al, l_reg, pa0, pa1, pa2, pa3); SBAR();                                                           \
            pv_tile<KB, false>(o, vb0, pa0, pa1, pa2, pa3, true);                                                              \
        }                                                                                                                      \
        SBAR();                                                                                                                \
        if ((t) + 1 < NT) { VMW(); SWRITE_KV((KB) ^ 1); }                                                                      \
        __syncthreads(); } while (0)
    for (int t = 0; t < NT; t += 2) { STEP(t, 0); STEP(t + 1, 1); }
    if (hi == 0) li_l[r32] = l_reg; asm volatile("s_waitcnt lgkmcnt(0)" ::: "memory");
    float rli[16];
#pragma unroll
    for (int r = 0; r < 16; ++r) rli[r] = __builtin_amdgcn_rcpf(li_l[crow(r, hi)]);
    bf16* Ow = cur.O + (size_t)(wid * QBLK) * LDO;
#pragma unroll
    for (int r = 0; r < 16; ++r) { const int orow = crow(r, hi);
#pragma unroll
        for (int d0 = 0; d0 < 4; ++d0) { const float v = o[d0][r] * rli[r];
            const float vn = __shfl_xor(v, 1);
            if ((r32 & 1) == 0) *(unsigned*)(Ow + (size_t)orow * LDO + d0 * 32 + r32) = cvtpk(v, vn); } }
    __syncthreads();
#undef RESC
#undef KBASE
#undef ACT
#undef MASKT
#undef STEP
}
#if ATT_PIPE_FOX || ATT_PIPE_MLA
template <int MODE>
__device__ __forceinline__ void attn_prime(const BlockRef& cur, char* lds, Seam<MODE>& S) {
    int tid_ = threadIdx.x; asm volatile("" : "+v"(tid_));
    const int tid = tid_, wid = __builtin_amdgcn_readfirstlane(tid >> 6), lane = tid & 63, r32 = lane & 31, hi = lane >> 5;
    const int sr = tid >> 4, sc = (tid & 15) * 8, kws = KSWZ(sr, sc * 2), krws = KSWZ((tid >> 3) & 31, ((tid >> 8) * 64 + (tid & 7) * 8) * 2);
    QLOAD(cur);
    SLOAD(cur, 0); VMW(); SWRITE_K(0);
    __syncthreads();
}
template <int MODE>
__device__ __forceinline__ void attn_block(const BlockRef& cur, const BlockRef& nxt, char* lds, Seam<MODE>& S) {
    constexpr bool SK = (MODE == 1);
    int tid_ = threadIdx.x; asm volatile("" : "+v"(tid_));
    const int tid = tid_, wid = __builtin_amdgcn_readfirstlane(tid >> 6), lane = tid & 63, r32 = lane & 31, hi = lane >> 5;
    const int NT = (cur.P0 + QB) / KVBLK;
    const int qlo = cur.P0 + wid * QBLK, qm = qlo + r32 - 4 * hi;
    float* ws = (float*)(lds + OFF_WS) + wid * 64; float* li_l = ws, * al_l = ws + 32;
    float m_reg = -1e30f, l_reg = 0; f32x16 o[4] = {};
    const int sr = tid >> 4, sc = (tid & 15) * 8, vst0 = v_st(sr, sc), vst1 = v_st(32 + sr, sc), kws = KSWZ(sr, sc * 2), krws = KSWZ((tid >> 3) & 31, ((tid >> 8) * 64 + (tid & 7) * 8) * 2);
    const int vb0 = (int)(uintptr_t)(lds + OFF_V) + v_rd_base(lane);
#define RESC(a) do { if (__any((a) < 1.f)) { if (hi == 0) al_l[r32] = (a); asm volatile("s_waitcnt lgkmcnt(0)" ::: "memory");              \
                     for (int d_ = 0; d_ < 4; ++d_) for (int r = 0; r < 16; ++r) o[d_][r] *= al_l[crow(r, hi)]; } } while (0)
#define KBASE(t) ((t) * KVBLK)
#define ACT(t) (!SK || ((t) <= (qlo >> 6)))
#define MASKT(P0_, P1_, t) do { if (MODE == 0) { const int kb_ = KBASE(t); if (kb_ + KVBLK - 1 > qlo) mask_tile(P0_, P1_, qm - kb_); } } while (0)
    constexpr int NQL = Cfg<MODE>::NQ;
#define SEAM_K0() do { VMWN(NQL); SWRITE_K(0); SBAR(); } while (0)
    f32x16 pA0, pA1, pB0, pB1; float mnA, mnB, alA, alB; bf16x8 pa0, pa1, pa2, pa3;
    SWRITE_V(0); SBAR();
    if (NT > 1) SLOAD(cur, KBASE(1));
    SBAR(); qkt<0, MODE>(pA0, pA1, lds, r32, hi, S.qr, ACT(0));
    MASKT(pA0, pA1, 0); partialSM<MODE>(pA0, pA1, m_reg, mnA, alA);
    if (NT > 1) { VMW(); SWRITE_KV(1); }
    __syncthreads();
#define HALF_STEP(PX0, PX1, mnX, alX, PY0, PY1, alY, t, KB, VB, SB) do {                                                      \
        SBAR(); qkt<KB, MODE>(PX0, PX1, lds, r32, hi, S.qr, ACT(t));                                             \
        finishSM(PY0, PY1, alY, l_reg, pa0, pa1, pa2, pa3); SBAR();                                                           \
        if ((t) + 1 < NT) { SLOAD(cur, KBASE((t) + 1)); SBAR(); }                                               \
        pv_tile<VB, SK>(o, vb0, pa0, pa1, pa2, pa3, ACT((t) - 1)); MASKT(PX0, PX1, (t)); partialSM<MODE>(PX0, PX1, m_reg, mnX, alX);      \
        __syncthreads();                                                                                                      \
        if ((t) + 1 < NT) { VMW(); SWRITE_KV(SB); }                                                                          \
        RESC(alX); __syncthreads(); } while (0)
    for (int t = 1; t + 1 < NT; t += 2) {
        HALF_STEP(pB0, pB1, mnB, alB, pA0, pA1, alA, t, 1, 0, 0);
        HALF_STEP(pA0, pA1, mnA, alA, pB0, pB1, alB, t + 1, 0, 1, 1);
    }
    const bool even = (NT & 1) == 0;
    if (even) { SBAR(); qkt<1, MODE>(pB0, pB1, lds, r32, hi, S.qr, ACT(NT - 1)); SBAR(); }
    SLOAD(nxt, 0); SBAR();
    QLOAD(nxt);
    SBAR();
    finishSM(pA0, pA1, alA, l_reg, pa0, pa1, pa2, pa3); SBAR();
    pv_tile<0, SK>(o, vb0, pa0, pa1, pa2, pa3, ACT(even ? NT - 2 : NT - 1));
    if (even) { MASKT(pB0, pB1, NT - 1); partialSM<MODE>(pB0, pB1, m_reg, mnB, alB); __syncthreads(); RESC(alB);
        finishSM(pB0, pB1, alB, l_reg, pa0, pa1, pa2, pa3); SBAR(); pv_tile<1, SK>(o, vb0, pa0, pa1, pa2, pa3, ACT(NT - 1)); }
    SBAR(); SEAM_K0();
    if (hi == 0) li_l[r32] = l_reg; asm volatile("s_waitcnt lgkmcnt(0)" ::: "memory");
    float rli[16];
#pragma unroll
    for (int r = 0; r < 16; ++r) rli[r] = __builtin_amdgcn_rcpf(li_l[crow(r, hi)]);
    bf16* Ow = cur.O + (size_t)(wid * QBLK) * LDO;
#pragma unroll
    for (int r = 0; r < 16; ++r) { const int orow = crow(r, hi);
#pragma unroll
        for (int d0 = 0; d0 < 4; ++d0) { const float v = o[d0][r] * rli[r];
            const float vn = __shfl_xor(v, 1);
            if ((r32 & 1) == 0) *(unsigned*)(Ow + (size_t)orow * LDO + d0 * 32 + r32) = cvtpk(v, vn); } }
    __syncthreads();
#undef RESC
#undef KBASE
#undef ACT
#undef MASKT
#undef SEAM_K0
#undef HALF_STEP
}
#endif
#undef ROWKV
#undef VMW
#undef VMWN
#undef SLOAD
#undef SWRITE_K
#undef SWRITE_V
#undef SWRITE_KV
#undef QLOAD
#undef KSWZ
#undef SBAR
}
#define GAS __attribute__((address_space(1)))
#define LAS __attribute__((address_space(3)))
typedef unsigned short bf16b;
typedef unsigned v4u __attribute__((ext_vector_type(4)));
typedef float f32x4 __attribute__((ext_vector_type(4)));
constexpr size_t MiB = 1u << 20;
constexpr size_t WS_SQ = 1008 * MiB, WS_SKV = 1009 * MiB, WS_SH1 = 1010 * MiB, WS_SH2 = 1014 * MiB;
constexpr size_t WS_ROPE = 1 * MiB;
constexpr size_t WS_WIN = 4 * MiB, WS_WUQ = 36 * MiB, WS_WUKV = 38 * MiB, WS_WM = 40 * MiB, WS_WF = 44 * MiB, WS_WOUT = 48 * MiB, WS_WUP = 56 * MiB, WS_WDOWN = 88 * MiB;
constexpr size_t WS_XN = 120 * MiB;
constexpr size_t WS_CQ = 248 * MiB, WS_CKV = 280 * MiB, WS_KR = 296 * MiB, WS_FF = 300 * MiB, WS_BIAS = 301 * MiB;
constexpr size_t WS_FQ = 304 * MiB;
constexpr size_t WS_GATES = 496 * MiB;
constexpr size_t WS_KN = 752 * MiB, WS_VM = 816 * MiB, WS_OM = 880 * MiB, WS_OF = 944 * MiB, WS_END = 1018 * MiB;
constexpr size_t WS_U = 432 * MiB;
constexpr int LDS_TOTAL = 131072 + 1024;
static_assert(att::LDS_BYTES <= 131072, "attention LDS");

#define XB_TMO      128
#define XB_XCNT(j)  (256  + 64 * (j))
#define XB_XSUB(j)  (1280 + 64 * (j))
#define XB_XGEN(j)  (2304 + 64 * (j))
#define XB_TOP      3328
#define XB_TOPGEN   3392
#define XCD_BAR_WORDS 3456
#define XB_SPIN_CAP (1u << 18)

__device__ __forceinline__ unsigned xb_ld(unsigned* p)              { return __hip_atomic_load(p, __ATOMIC_RELAXED, __HIP_MEMORY_SCOPE_AGENT); }
__device__ __forceinline__ unsigned xb_add(unsigned* p, unsigned v) { return __hip_atomic_fetch_add(p, v, __ATOMIC_RELAXED, __HIP_MEMORY_SCOPE_AGENT); }
__device__ __forceinline__ unsigned xb_xcc_id() { return (unsigned)__builtin_amdgcn_s_getreg((3 << 11) | 20) & 0xFu; }
#define XB_SPIN(cond, bar) do { unsigned _sp = 0; while (cond) { __builtin_amdgcn_s_sleep(1); \
    if ((++_sp & 255u) == 0u) { if (xb_ld(&(bar)[XB_TMO])) break; if (_sp > XB_SPIN_CAP) { atomicAdd(&(bar)[XB_TMO], 1u); break; } } } } while (0)

struct XcdBarrier {
    unsigned* bar; unsigned x;
    volatile LAS unsigned* st;
};

__device__ __forceinline__ XcdBarrier xcd_barrier_post(unsigned* bar, volatile LAS unsigned* st) {
    XcdBarrier b; b.bar = bar; b.x = xb_xcc_id(); b.st = st;
    if (threadIdx.x == 0) (void)xb_add(&bar[XB_XCNT(b.x)], 1u);
    return b;
}
__device__ __forceinline__ void xcd_barrier_complete(unsigned* bar, unsigned x, unsigned& nloc, unsigned& nx) {
    const unsigned G = gridDim.x * gridDim.y * gridDim.z;
    unsigned sum, cnt, mine, sp = 0u;
    for (;;) {
        sum = 0u; cnt = 0u; mine = 0u;
#pragma unroll
        for (unsigned j = 0; j < 16; ++j) { const unsigned c = xb_ld(&bar[XB_XCNT(j)]); sum += c; cnt += (c > 0u) ? 1u : 0u; mine = (j == x) ? c : mine; }
        if (sum == G) break;
        __builtin_amdgcn_s_sleep(1);
        if ((++sp & 255u) == 0u) { if (xb_ld(&bar[XB_TMO])) break; if (sp > XB_SPIN_CAP) { atomicAdd(&bar[XB_TMO], 1u); break; } }
    }
    nloc = mine > 0u ? mine : 1u; nx = cnt > 0u ? cnt : 1u;
}

__device__ __forceinline__ void xcd_barrier(const XcdBarrier& b) {
    asm volatile("s_waitcnt vmcnt(0)" ::: "memory");
    __syncthreads();
    if (threadIdx.x == 0) {
        unsigned* bar = b.bar;
        __builtin_amdgcn_s_waitcnt(0);
        unsigned nloc = b.st[0], nx = b.st[1];
        if (nloc == 0u) { xcd_barrier_complete(bar, b.x, nloc, nx); b.st[0] = nloc; b.st[1] = nx; }
        const unsigned old = xb_add(&bar[XB_XSUB(b.x)], 1u);
        const unsigned gen = old / nloc;
        if (old + 1u == (gen + 1u) * nloc) {
            __builtin_amdgcn_fence(__ATOMIC_RELEASE, "agent");
            asm volatile("s_waitcnt vmcnt(0)" ::: "memory");
            const unsigned og = xb_add(&bar[XB_TOP], 1u);
            const unsigned tg = og / nx;
            if (og + 1u == (tg + 1u) * nx) xb_add(&bar[XB_TOPGEN], 1u);
            else XB_SPIN(xb_ld(&bar[XB_TOPGEN]) == tg, bar);
            __builtin_amdgcn_fence(__ATOMIC_ACQUIRE, "agent");
            xb_add(&bar[XB_XGEN(b.x)], 1u);
            asm volatile("s_waitcnt vmcnt(0)" ::: "memory");
        } else {
            XB_SPIN(xb_ld(&bar[XB_XGEN(b.x)]) == gen, bar);
            __builtin_amdgcn_fence(__ATOMIC_ACQUIRE, "agent");
            asm volatile("s_waitcnt vmcnt(0)" ::: "memory");
        }
    }
    __syncthreads();
}

constexpr size_t WS_PCNT = 3 * MiB + 512 * 1024;
constexpr size_t WS_BAR = 3 * MiB;

struct Own { int xi, nx, lr, nloc; };
#ifndef BATCH_MAP
#define BATCH_MAP 1
#endif
__device__ __forceinline__ int own_panel(const Own& o, int k) {
    if (BATCH_MAP && o.nx == 8 && MROWS / 256 == 128) { if (k >= 16) return 1 << 20; const int s = o.xi & 1, qb = s ? 8 + k : (k < 8 ? k : 16 + k); return 32 * (o.xi >> 1) + qb; }
    return k * o.nx + ((k & 1) ? o.nx - 1 - o.xi : o.xi); }
__device__ __forceinline__ int own_npan(const Own& o, int nM) { int n = 0; while (own_panel(o, n) < nM) ++n; return n; }
#ifndef XGM
#define XGM 4
#endif
struct XOrder {
    Own o; int nN, npan, nunits;
    __device__ __forceinline__ void init(int M, int N, const Own& o_) { o = o_; if (!OWN_GEMM) { o.nx = 8; o.nloc = gridDim.x / 8; o.xi = blockIdx.x % 8; o.lr = blockIdx.x / 8; } nN = N / 256; npan = own_npan(o, M / 256); nunits = npan * nN; }
    __device__ __forceinline__ bool next(int i, pg8::Unit& u) const {
        const int L = i * o.nloc + o.lr; if (L >= nunits) return false;
        const int nig = XGM * nN, gid = L / nig, fm = gid * XGM, gsz = (npan - fm) < XGM ? (npan - fm) : XGM, r = L - gid * nig;
        u.pm = own_panel(o, fm + r % gsz); u.pn = r / gsz; return true;
    }
    __device__ __forceinline__ void a_ready(const pg8::Unit&) const {}
    __device__ __forceinline__ void done(const pg8::Unit&) const {}
};
#ifndef CUT_MASK
#define CUT_MASK (MK_MULTI ? 0xff : 0)
#endif
struct Args { const float* in[15]; float* out; unsigned char* ws; int ph_lo, ph_hi, li, pad; };

__device__ __forceinline__ unsigned f2bf(float f) { unsigned u = __builtin_bit_cast(unsigned, f); return (u + 0x7fffu + ((u >> 16) & 1u)) >> 16; }
__device__ __forceinline__ unsigned pk2(float lo, float hi) { return f2bf(lo) | (f2bf(hi) << 16); }
__device__ __forceinline__ float wave_sum(float v) {
#pragma unroll
    for (int o = 1; o < 64; o <<= 1) v += __shfl_xor(v, o);
    return v;
}
__device__ __forceinline__ int map_col(int id, int j) {
    if (id == 1) { if (j < 768) return j; if (j < 832) { const int i = j - 768; return 768 + (i < 32 ? 2 * i : 2 * (i - 32) + 1); }
                   if (j < 3904) return 1024 + (j - 832); if (j < 3912) return 832 + (j - 3904); return 4096 + (j - 3912); }
    if (id == 2) { const int h = j / 192, r = j - h * 192; if (r < 128) return j; const int i = r - 128; return 192 * h + 128 + (i < 32 ? 2 * i : 2 * (i - 32) + 1); }
    if (id == 3) { const int h = j >> 8, r = j & 255; return r < 128 ? 128 * h + r : 1024 + 128 * h + (r - 128); }
    return j;
}
__device__ __forceinline__ void p0_transpose_item(const float* W, int K, int N, bf16b* WT, const float* gain, int mapid, LAS float* scr, int item, int lane) {
    const int nblk = (N + 31) / 32, kb = item / nblk, nb = item - kb * nblk, k0 = 64 * kb, n0 = 32 * nb;
    const int col = n0 + (lane & 31);
#pragma unroll 8
    for (int i = 0; i < 32; ++i) { const int kk = 2 * i + (lane >> 5); float v = 0.f; if (col < N) { v = W[(size_t)(k0 + kk) * N + col]; if (gain) v *= gain[k0 + kk]; } scr[kk * 33 + (lane & 31)] = v; }
    asm volatile("s_waitcnt lgkmcnt(0)" ::: "memory");
    const int c = lane & 7;
#pragma unroll
    for (int j = 0; j < 4; ++j) { const int n = (lane >> 3) + 8 * j; const LAS float* s = scr + (8 * c) * 33 + n;
        if (n0 + n < N) { v4u o; o.x = pk2(s[0 * 33], s[1 * 33]); o.y = pk2(s[2 * 33], s[3 * 33]); o.z = pk2(s[4 * 33], s[5 * 33]); o.w = pk2(s[6 * 33], s[7 * 33]);
            *(v4u*)(WT + (size_t)map_col(mapid, n0 + n) * K + k0 + 8 * c) = o; } }
    asm volatile("s_waitcnt lgkmcnt(0)" ::: "memory");
}


struct TDesc { const float* W; const float* gain; bf16b* WT; int K, N, mapid, item; };
__device__ __forceinline__ void p0_item_load(const TDesc& d, int lane, f32x4 (&v)[8], float (&g)[8]) {
    const int nblk = (d.N + 31) / 32, kb = d.item / nblk, nb = d.item - kb * nblk, k0 = 64 * kb, col = 32 * nb + 4 * (lane & 7), kr = lane >> 3;
#pragma unroll
    for (int i = 0; i < 8; ++i) { const int k = k0 + 8 * i + kr; v[i] = (f32x4){0.f, 0.f, 0.f, 0.f}; if (col < d.N) v[i] = *(const f32x4*)(d.W + (size_t)k * d.N + col); g[i] = d.gain ? d.gain[k] : 1.f; }
}
__device__ __forceinline__ void p0_item_store(const TDesc& d, int lane, const f32x4 (&v)[8], const float (&g)[8], LAS float* scr) {
    const int nblk = (d.N + 31) / 32, kb = d.item / nblk, nb = d.item - kb * nblk, k0 = 64 * kb, n0 = 32 * nb, kr = lane >> 3, c4 = lane & 7;
#pragma unroll
    for (int i = 0; i < 8; ++i) { LAS float* s = scr + (8 * i + kr) * 33 + 4 * c4; const f32x4 xv = v[i] * g[i]; s[0] = xv.x; s[1] = xv.y; s[2] = xv.z; s[3] = xv.w; }
    asm volatile("s_waitcnt lgkmcnt(0)" ::: "memory");
    const int c = lane & 7;
#pragma unroll
    for (int j = 0; j < 4; ++j) { const int n = (lane >> 3) + 8 * j; const LAS float* s = scr + (8 * c) * 33 + n;
        if (n0 + n < d.N) { v4u o; o.x = pg8::cvt_pk_bf16(s[0 * 33], s[1 * 33]); o.y = pg8::cvt_pk_bf16(s[2 * 33], s[3 * 33]); o.z = pg8::cvt_pk_bf16(s[4 * 33], s[5 * 33]); o.w = pg8::cvt_pk_bf16(s[6 * 33], s[7 * 33]);
            *(v4u*)(d.WT + (size_t)map_col(d.mapid, n0 + n) * d.K + k0 + 8 * c) = o; } }
    asm volatile("s_waitcnt lgkmcnt(0)" ::: "memory");
}

__global__ void __launch_bounds__(512) fwd_megakernel(Args args) {
    extern __shared__ __attribute__((aligned(16))) unsigned char lds[];
    LAS unsigned char* ldsL = (LAS unsigned char*)lds;
    const int tid = threadIdx.x, lane = tid & 63, wave = __builtin_amdgcn_readfirstlane(tid >> 6);
    const int G = gridDim.x, bx = blockIdx.x;
    const int vcu = (G % 8 == 0) ? (bx % 8) * (G / 8) + bx / 8 : bx;
    unsigned char* ws = args.ws;
    const float* x = args.in[0];
    float* out = args.out;
    float* SQ = (float*)(ws + WS_SQ); float* SKV = (float*)(ws + WS_SKV); float* SH1 = (float*)(ws + WS_SH1); float* SH2 = (float*)(ws + WS_SH2); float* ROPE = (float*)(ws + WS_ROPE);
    bf16b* Win_t = (bf16b*)(ws + WS_WIN); bf16b* Wuq_t = (bf16b*)(ws + WS_WUQ); bf16b* Wukv_t = (bf16b*)(ws + WS_WUKV); bf16b* Wm_t = (bf16b*)(ws + WS_WM);
    bf16b* Wf_t = (bf16b*)(ws + WS_WF); bf16b* Wout_t = (bf16b*)(ws + WS_WOUT); bf16b* Wup_t = (bf16b*)(ws + WS_WUP); bf16b* Wdown_t = (bf16b*)(ws + WS_WDOWN);
    bf16b* XN = (bf16b*)(ws + WS_XN); bf16b* QM = XN; bf16b* MIX = XN;
    bf16b* CQ = (bf16b*)(ws + WS_CQ); bf16b* CKV = (bf16b*)(ws + WS_CKV); bf16b* KR = (bf16b*)(ws + WS_KR); float* FF = (float*)(ws + WS_FF); float* BIASK = (float*)(ws + WS_BIAS);
    bf16b* FQ = (bf16b*)(ws + WS_FQ); bf16b* H1B = FQ; bf16b* GATES = (bf16b*)(ws + WS_GATES);
    bf16b* KN = (bf16b*)(ws + WS_KN); bf16b* VM = (bf16b*)(ws + WS_VM); bf16b* OM = (bf16b*)(ws + WS_OM); bf16b* OF = (bf16b*)(ws + WS_OF); bf16b* U = (bf16b*)(ws + WS_U);
    const int lo = args.ph_lo, hi = args.ph_hi;
    volatile LAS unsigned* bst = (volatile LAS unsigned*)(ldsL + 131072);
    XcdBarrier bar; bar.bar = (unsigned*)(ws + WS_BAR) + args.li * XCD_BAR_WORDS; bar.x = xb_xcc_id(); bar.st = bst;
    if (tid == 0) {
        const unsigned lr_ = xb_add(&bar.bar[XB_XCNT(bar.x)], 1u);
        unsigned sum, cnt, mine, xi_, sp = 0u;
        for (;;) { sum = 0u; cnt = 0u; mine = 0u; xi_ = 0u;
#pragma unroll
            for (unsigned j = 0; j < 16; ++j) { const unsigned c = xb_ld(&bar.bar[XB_XCNT(j)]); sum += c; if (j == bar.x) { mine = c; xi_ = cnt; } cnt += (c > 0u) ? 1u : 0u; }
            if (sum == (unsigned)G) break;
            __builtin_amdgcn_s_sleep(1);
            if (++sp > (1u << 22)) break; }
        bst[0] = mine > 0u ? mine : 1u; bst[1] = cnt > 0u ? cnt : 1u; bst[4] = xi_; bst[5] = lr_;
    }
    __syncthreads();
    Own own; own.nloc = (int)bst[0]; own.nx = (int)bst[1]; own.xi = (int)bst[4]; own.lr = (int)bst[5];
    own.nloc = __builtin_amdgcn_readfirstlane(own.nloc); own.nx = __builtin_amdgcn_readfirstlane(own.nx); own.xi = __builtin_amdgcn_readfirstlane(own.xi); own.lr = __builtin_amdgcn_readfirstlane(own.lr);
    if (args.ph_lo < 0) cg::this_grid().sync();
#ifndef PHMASK
#define PHMASK 0x1ff
#endif
#define IN(k) (((PHMASK >> (k)) & 1) && lo <= (k) && (k) < hi)
#ifndef REPMASK
#define REPMASK 0
#endif
#define REP(k) (((REPMASK >> (k)) & 1) ? 2 : 1)
#define SEAM(k) do { if (IN(k) && IN((k) + 1)) xcd_barrier(bar); } while (0)
    pg8::Epi E{}; E.CQ = CQ; E.CKV = CKV; E.KR = KR; E.FQKV = FQ; E.GATES = GATES; E.QM = QM; E.KN = KN; E.VM = VM; E.MIX = MIX; E.TMP = FQ; E.H1B = H1B; E.U = U;
    E.GN = args.in[14]; E.PCNT = (unsigned*)(ws + WS_PCNT); E.fuse8 = (!MK_MULTI && CUT_MASK == 0 && XGM == 4 && own.nloc == 32) ? 1 : 0;
    E.FF = FF; E.SQ = SQ; E.SKV = SKV; E.SH1 = SH1; E.SH2 = SH2; E.OUT = out; E.X = x; E.ROPE = ROPE;

    if (IN(0)) for (int rp_ = 0; rp_ < REP(0); ++rp_) {
        const int gw = bx * 8 + wave, NGW = G * 8;
        LAS float* scr = (LAS float*)(ldsL + wave * 16384);
        constexpr int I_IN = 32 * 251, I_UQ = 8 * 48, I_UKV = 4 * 64, I_BR = 16 * 64, I_OUT = 32 * 64, I_UP = 32 * 256, I_DN = 128 * 64;
        constexpr int NITEMS = I_IN + I_UQ + I_UKV + 2 * I_BR + I_OUT + I_UP + I_DN;
#define P0_DECODE(D, it_) do { int r = (it_); \
            if (r < I_IN) { (D) = TDesc{args.in[2], args.in[1], Win_t, 2048, DIN, 1, r}; } else { r -= I_IN; \
            if (r < I_UQ) { (D) = TDesc{args.in[5], args.in[4], Wuq_t, 512, 1536, 2, r}; } else { r -= I_UQ; \
            if (r < I_UKV) { (D) = TDesc{args.in[7], args.in[6], Wukv_t, 256, 2048, 3, r}; } else { r -= I_UKV; \
            if (r < I_BR) { (D) = TDesc{args.in[8], nullptr, Wm_t, 1024, 2048, 0, r}; } else { r -= I_BR; \
            if (r < I_BR) { (D) = TDesc{args.in[9], nullptr, Wf_t, 1024, 2048, 0, r}; } else { r -= I_BR; \
            if (r < I_OUT) { (D) = TDesc{args.in[10], nullptr, Wout_t, 2048, 2048, 0, r}; } else { r -= I_OUT; \
            if (r < I_UP) { (D) = TDesc{args.in[12], args.in[11], Wup_t, 2048, 8192, 0, r}; } else { r -= I_UP; \
            (D) = TDesc{args.in[13], nullptr, Wdown_t, 8192, 2048, 0, r}; } } } } } } } } while (0)
        if (gw < NITEMS) {
            int it = gw; TDesc dc; P0_DECODE(dc, it); f32x4 vc[8]; float gc[8]; p0_item_load(dc, lane, vc, gc);
            for (;;) { const int itn = it + NGW; const bool has = itn < NITEMS; TDesc dn = dc; f32x4 vn[8]; float gn[8];
                if (has) { P0_DECODE(dn, itn); p0_item_load(dn, lane, vn, gn); }
                p0_item_store(dc, lane, vc, gc, scr);
                if (!has) break;
#pragma unroll
                for (int i = 0; i < 8; ++i) { vc[i] = vn[i]; gc[i] = gn[i]; }
                dc = dn; it = itn; }
        }
#undef P0_DECODE
        Own ownr = own; if (!OWN_ROWS) { ownr.nx = 8; ownr.nloc = G / 8; ownr.xi = bx % 8; ownr.lr = bx / 8; }
        const int npan0 = own_npan(ownr, MROWS / 256), xend = npan0 * 256, xstep = ownr.nloc * 8;
        { int idx = ownr.lr * 8 + wave;
          if (idx < xend) { f32x4 v[8]; int m = own_panel(ownr, idx >> 8) * 256 + (idx & 255);
#pragma unroll
            for (int j = 0; j < 8; ++j) v[j] = ((const f32x4*)(x + (size_t)m * DMODEL) + lane)[64 * j];
            for (;;) { const int idn = idx + xstep; const bool has = idn < xend; f32x4 w[8]; int mn = m;
                if (has) { mn = own_panel(ownr, idn >> 8) * 256 + (idn & 255);
#pragma unroll
                    for (int j = 0; j < 8; ++j) w[j] = ((const f32x4*)(x + (size_t)mn * DMODEL) + lane)[64 * j]; }
                float s = 0.f;
#pragma unroll
                for (int j = 0; j < 8; ++j) s += (v[j].x * v[j].x + v[j].y * v[j].y) + (v[j].z * v[j].z + v[j].w * v[j].w);
                const float rs = rsqrtf(wave_sum(s) * (1.f / DMODEL) + EPS);
                unsigned long long* o8 = (unsigned long long*)(XN + (size_t)m * DMODEL) + lane;
#pragma unroll
                for (int j = 0; j < 8; ++j) o8[64 * j] = (unsigned long long)pg8::cvt_pk_bf16(v[j].x * rs, v[j].y * rs) | ((unsigned long long)pg8::cvt_pk_bf16(v[j].z * rs, v[j].w * rs) << 32);
                if (!has) break;
#pragma unroll
                for (int j = 0; j < 8; ++j) v[j] = w[j];
                idx = idn; m = mn; } } }
        const int gt = bx * 512 + tid, NGT = G * 512;
        for (int i = gt; i < SEQ * 32; i += NGT) { const int pos = i >> 5, k = i & 31;
            const float inv = 1.0f / powf(10000.0f, (float)k * (1.0f / 32.0f)); const float ang = (float)pos * inv;
            const double rev = (double)ang * 0.15915494309189535; const float fr = (float)(rev - __builtin_rint(rev));
            ROPE[2 * i] = __builtin_amdgcn_cosf(fr); ROPE[2 * i + 1] = __builtin_amdgcn_sinf(fr); }
    }
    SEAM(0);
    if (IN(1)) for (int rp_ = 0; rp_ < REP(1); ++rp_) { pg8::Gemm g{XN, Win_t, MROWS, NPROJ, 2048}; XOrder S; S.init(MROWS, NPROJ, own); E.mode = EM_PROJ;
        pg8::gemm_phase<pg8::Epi, XOrder, true, true>(ldsL, g, S, E); }
    SEAM(1);
    if (IN(2)) for (int rp_ = 0; rp_ < REP(2); ++rp_) {
        if (bx < 32) {
            const int b = bx >> 3, h = bx & 7; const float fb = args.in[3][h]; float v[16]; float run = 0.f;
#pragma unroll
            for (int i = 0; i < 16; ++i) { const float z = FF[((size_t)b * SEQ + tid * 16 + i) * 8 + h] + fb; const float ls = fminf(z, 0.f) - log1pf(expf(-fabsf(z))); run += ls; v[i] = run; }
            float incl = run;
#pragma unroll
            for (int o = 1; o < 64; o <<= 1) { const float t = __shfl_up(incl, o); if (lane >= o) incl += t; }
            LAS float* wt = (LAS float*)ldsL;
            if (lane == 63) wt[wave] = incl;
            __syncthreads();
            float base = incl - run;
            for (int w = 0; w < wave; ++w) base += wt[w];
            float* dst = BIASK + ((size_t)bx * SEQ + tid * 16);
#pragma unroll
            for (int i = 0; i < 16; ++i) dst[i] = -(base + v[i]) * 11.313708498984761f;
            __syncthreads();
        }
        { pg8::Gemm g{CQ, Wuq_t, MROWS, 1536, 512}; XOrder S; S.init(MROWS, 1536, own); E.mode = EM_QUP;
          pg8::gemm_phase<pg8::Epi, XOrder, true, true>(ldsL, g, S, E); }
        { pg8::Gemm g{CKV, Wukv_t, MROWS, 2048, 256}; XOrder S; S.init(MROWS, 2048, own); E.mode = EM_KVUP;
          pg8::gemm_phase<pg8::Epi, XOrder, true, true>(ldsL, g, S, E); }
    }
    SEAM(2);
    if (IN(3)) {
        using att::bf16; using att::BlockRef;
        Own owna = own; if (!OWN_ATT) { owna.nx = 8; owna.nloc = G / 8; owna.xi = bx % 8; owna.lr = bx / 8; }
        const int npanA = own_npan(owna, MROWS / 256); const bool fastdeal = (owna.nx == 8 && owna.nloc == 32 && npanA == 16);
#define MKREF(R, MODE_, e_) do { int pm_, h_; if (fastdeal && BATCH_MAP) { const int i_ = (e_) >> 6, which_ = ((e_) >> 5) & 1, l_ = (e_) & 31, p_ = l_ & 7, s_ = owna.xi & 1; h_ = 4 * i_ + (l_ >> 3); \
                pm_ = 32 * (owna.xi >> 1) + (which_ == 0 ? (s_ ? 23 - p_ : 31 - p_) : (s_ ? 8 + p_ : p_)); }     \
            else if (fastdeal) { const int j_ = (e_) & 31, i_ = (e_) >> 5; pm_ = own_panel(owna, (j_ >> 3) * 4 + i_); h_ = j_ & 7; } else { pm_ = own_panel(owna, (e_) >> 3); h_ = (e_) & 7; } \
            const int b_ = pm_ >> 5, qb_ = pm_ & 31, grp_ = b_ * 8 + h_; const size_t rb_ = (size_t)b_ * SEQ, rq_ = rb_ + (size_t)qb_ * 256; (R).P0 = qb_ * 256; \
            if ((MODE_) == 0) { (R).Q = (const bf16*)FQ + rq_ * 1024 + h_ * 128; (R).K = (const bf16*)FQ + (size_t)MROWS * 1024 + rb_ * 1024 + h_ * 128; (R).V = (const bf16*)FQ + (size_t)MROWS * 2048 + rb_ * 1024 + h_ * 128; \
                (R).O = (bf16*)OF + rq_ * 1024 + h_ * 128; (R).KR = nullptr; (R).BIAS = BIASK + (size_t)grp_ * SEQ; } \
            else { (R).Q = (const bf16*)QM + rq_ * 1536 + h_ * 192; (R).K = (const bf16*)KN + rb_ * 1024 + h_ * 128; (R).V = (const bf16*)VM + rb_ * 1024 + h_ * 128; \
                (R).O = (bf16*)OM + rq_ * 1024 + h_ * 128; (R).KR = (const bf16*)KR + rb_ * 64; (R).BIAS = nullptr; } } while (0)
#define STREAM(MODE_) do { for (int e = owna.lr; e < npanA * 8; e += owna.nloc) { BlockRef cur; MKREF(cur, MODE_, e); att::attn_block_np<MODE_>(cur, (char*)lds); } } while (0)
#if ATT_PIPE_FOX || ATT_PIPE_MLA
#define STREAMP(MODE_) do { int e = owna.lr; if (e < npanA * 8) { BlockRef cur, nxt; MKREF(cur, MODE_, e); att::Seam<MODE_> S; att::attn_prime<MODE_>(cur, (char*)lds, S); \
            for (;;) { const int en = e + owna.nloc; const bool last = en >= npanA * 8; if (last) nxt = cur; else MKREF(nxt, MODE_, en); \
                att::attn_block<MODE_>(cur, nxt, (char*)lds, S); if (last) break; cur = nxt; e = en; } } } while (0)
#endif
#ifndef ATT_REPEAT
#define ATT_REPEAT 1
#endif
        for (int rep = 0; rep < ATT_REPEAT; ++rep) {
#ifndef NO_FOX
#if ATT_PIPE_FOX
        STREAMP(0);
#else
        STREAM(0);
#endif
#endif
#ifndef NO_MLA
#if ATT_PIPE_MLA
        STREAMP(1);
#else
        STREAM(1);
#endif
#endif
        }
#undef STREAM
#undef MKREF
    }
    SEAM(3);
    if (IN(4)) for (int rp_ = 0; rp_ < REP(4); ++rp_) {
        { pg8::Gemm g{OM, Wm_t, MROWS, 2048, 1024}; XOrder S; S.init(MROWS, 2048, own); E.mode = EM_BR1;
          pg8::gemm_phase<pg8::Epi, XOrder, true, true>(ldsL, g, S, E); }
        { pg8::Gemm g{OF, Wf_t, MROWS, 2048, 1024}; XOrder S; S.init(MROWS, 2048, own); E.mode = EM_BR2;
          pg8::gemm_phase<pg8::Epi, XOrder, true, true>(ldsL, g, S, E); }
    }
    SEAM(4);
    if (IN(5)) for (int rp_ = 0; rp_ < REP(5); ++rp_) { pg8::Gemm g{MIX, Wout_t, MROWS, 2048, 2048}; XOrder S; S.init(MROWS, 2048, own); E.mode = EM_OUT;
        pg8::gemm_phase<pg8::Epi, XOrder, true, true>(ldsL, g, S, E); }
    SEAM(5);
    if (IN(6)) for (int rp_ = 0; rp_ < REP(6); ++rp_) { pg8::Gemm g{H1B, Wup_t, MROWS, DFF, 2048}; XOrder S; S.init(MROWS, DFF, own); E.mode = EM_UP;
        pg8::gemm_phase<pg8::Epi, XOrder, true, true>(ldsL, g, S, E); }
    SEAM(6);
    if (IN(7)) { pg8::Gemm g{U, Wdown_t, MROWS, 2048, DFF}; XOrder S; S.init(MROWS, 2048, own); E.mode = EM_DOWN;
        pg8::gemm_phase<pg8::Epi, XOrder, true, true>(ldsL, g, S, E); }
    SEAM(7);
    if (IN(8) && !E.fuse8) {
        const float* gn = args.in[14]; Own ownr = own; if (!OWN_ROWS) { ownr.nx = 8; ownr.nloc = G / 8; ownr.xi = bx % 8; ownr.lr = bx / 8; } const int npan8 = own_npan(ownr, MROWS / 256);
        f32x4 gv[8];
#pragma unroll
        for (int j = 0; j < 8; ++j) gv[j] = ((const f32x4*)gn)[lane + 64 * j];
        for (int idx = ownr.lr * 8 + wave; idx < npan8 * 256; idx += ownr.nloc * 8) { const int m = own_panel(ownr, idx >> 8) * 256 + (idx & 255); f32x4* orow = (f32x4*)(out + (size_t)m * DMODEL) + lane; const int r_ = m & 255; float sq = lane < 32 ? SH2[((((size_t)(m >> 8) * 32 + lane) * 2 + ((r_ >> 6) & 1)) * 16 + (r_ & 15)) * 8 + (r_ >> 7) * 4 + ((r_ >> 4) & 3)] : 0.f; sq = wave_sum(sq); const float rs = rsqrtf(sq * (1.f / DMODEL) + EPS);
#pragma unroll
            for (int j = 0; j < 8; ++j) { f32x4 v = orow[64 * j]; orow[64 * j] = v * rs * gv[j]; } }
    }
#undef IN
#undef SEAM
}

extern "C" void kernel_launch(void* const* d_in, const int* in_sizes, int n_in, void* d_out, int out_size, void* d_ws, size_t ws_size, hipStream_t stream) {
    static int grid = 0;
    if (grid == 0) {
        if (n_in != 15 || in_sizes[0] != MROWS * DMODEL || out_size != MROWS * DMODEL || ws_size < WS_END) {
            fprintf(stderr, "kernel_launch: unexpected shapes (n_in %d, in0 %d, out %d, ws %zu < %zu)\n", n_in, n_in > 0 ? in_sizes[0] : -1, out_size, ws_size, (size_t)WS_END); grid = -1; return; }
        int dev = 0, cus = 0, per_cu = 0;
        (void)hipGetDevice(&dev); (void)hipDeviceGetAttribute(&cus, hipDeviceAttributeMultiprocessorCount, dev);
        if (hipFuncSetAttribute((const void*)fwd_megakernel, hipFuncAttributeMaxDynamicSharedMemorySize, LDS_TOTAL) != hipSuccess) { fprintf(stderr, "kernel_launch: hipFuncSetAttribute failed\n"); grid = -1; return; }
        if (hipOccupancyMaxActiveBlocksPerMultiprocessor(&per_cu, (const void*)fwd_megakernel, 512, LDS_TOTAL) != hipSuccess || per_cu < 1) { fprintf(stderr, "kernel_launch: occupancy query says %d\n", per_cu); per_cu = 1; }
        (void)hipGetLastError();
        if (cus <= 0) cus = 256;
        grid = cus;
    }
    if (grid < 0) return;
    Args a{};
    for (int i = 0; i < 15; ++i) a.in[i] = (const float*)d_in[i];
    a.out = (float*)d_out; a.ws = (unsigned char*)d_ws;
    (void)hipMemsetAsync((unsigned char*)d_ws + WS_BAR, 0, 512 * 1024 + 128 * 256, stream);
    int li = 0;
    for (int p = 0; p < 9; ) { int q = p; while (q < 8 && !((CUT_MASK >> q) & 1)) ++q;
        a.ph_lo = p; a.ph_hi = q + 1; a.li = li++;
        void* kargs[] = {&a};
        hipError_t e = hipLaunchCooperativeKernel((const void*)fwd_megakernel, dim3(grid), dim3(512), kargs, LDS_TOTAL, stream);
        if (e != hipSuccess) fprintf(stderr, "kernel_launch: cooperative launch failed: %s (grid %d)\n", hipGetErrorString(e), grid);
        p = q + 1; }
}
```

```cpp
#include <hip/hip_runtime.h>
#include <hip/hip_bf16.h>
#include <hip/hip_cooperative_groups.h>
#include <cstdio>
#include <cstdint>
namespace cg = cooperative_groups;

#ifndef MK_MULTI
#define MK_MULTI 0
#endif

#ifndef OWN_GEMM
#define OWN_GEMM 1
#endif
#ifndef OWN_ATT
#define OWN_ATT 1
#endif
#ifndef OWN_ROWS
#define OWN_ROWS 1
#endif
constexpr int BATCH = 4, SEQ = 8192, DMODEL = 2048, MROWS = BATCH * SEQ, DIN = 8008, NPROJ = 8192, DFF = 8192;
constexpr float EPS = 1e-6f;
enum { EM_PROJ = 0, EM_QUP, EM_KVUP, EM_BR1, EM_BR2, EM_OUT, EM_UP, EM_DOWN };
namespace pg8 {
#define PG8_LAS __attribute__((address_space(3)))
typedef unsigned short bf16_t;
typedef short bf16x8 __attribute__((ext_vector_type(8)));
typedef float f32x4 __attribute__((ext_vector_type(4)));
typedef unsigned u32x4 __attribute__((ext_vector_type(4)));
constexpr int BM = 256, BK = 64, HALF = 128, HTB = HALF * BK * 2  , STAGE_BYTES = 8 * HTB, NXCD = 8, WGM = 8;

__host__ __device__ __forceinline__ int lds_byte(int r, int c) { const int st = (r >> 4) * 2 + (c >> 5), rr = r & 15, cc = c & 31, ob = rr * 64 + cc * 2; return st * 1024 + (ob ^ (((ob >> 9) & 1) << 5)); }
__host__ __device__ __forceinline__ void stage_rc(int b, int& R, int& C) { const int st = b / 1024, sb = b % 1024, swz = sb ^ (((sb >> 9) & 1) << 5); R = (st >> 1) * 16 + swz / 64; C = (st & 1) * 32 + (swz % 64) / 2; }
__host__ __device__ __forceinline__ int perm32(int rho) { const int n = rho >> 4, i = rho & 15; return 8 * (i >> 2) + 4 * n + (i & 3); }

struct Unit { int pm, pn; };
struct Gemm { const bf16_t* A; const bf16_t* Bt; int M, N, K; };

struct StaticOrder {
    int nM, nN, nwg, G, c;
    __host__ __device__ void init(int M, int N, int G_, int c_) { nM = M / BM; nN = N / BM; nwg = nM * nN; G = G_; c = c_; }
    __host__ __device__ bool next(int i, Unit& u) const {
        const long L = (long)i * G + c; if (L >= nwg) return false;
        int wgid = (int)L; { const int q = nwg / NXCD, r = nwg % NXCD, xcd = wgid % NXCD, off = wgid / NXCD; wgid = (xcd < r ? xcd * (q + 1) : r * (q + 1) + (xcd - r) * q) + off; }
        const int nig = WGM * nN, gid = wgid / nig, fm = gid * WGM, gsz = (nM - fm) < WGM ? (nM - fm) : WGM;
        u.pm = fm + ((wgid % nig) % gsz); u.pn = (wgid % nig) / gsz; return true;
    }
    __device__ __forceinline__ void a_ready(const Unit&) const {}
    __device__ __forceinline__ void done(const Unit&) const {}
};

typedef float f32x2c_t __attribute__((ext_vector_type(2))); typedef __bf16 bf16x2c_t __attribute__((ext_vector_type(2)));
__device__ __forceinline__ unsigned cvt_pk_bf16(float lo, float hi) { f32x2c_t v = {lo, hi}; bf16x2c_t b = __builtin_convertvector(v, bf16x2c_t); return __builtin_bit_cast(unsigned, b); }
typedef float f32x2 __attribute__((ext_vector_type(2)));
typedef unsigned u32x2 __attribute__((ext_vector_type(2)));
__device__ __forceinline__ u32x4 pack8(f32x4 a, f32x4 b) { u32x4 w; w.x = cvt_pk_bf16(a[0], a[1]); w.y = cvt_pk_bf16(a[2], a[3]); w.z = cvt_pk_bf16(b[0], b[1]); w.w = cvt_pk_bf16(b[2], b[3]); return w; }
__device__ __forceinline__ void unpack8(u32x4 w, f32x4& a, f32x4& b) {
    a[0] = __uint_as_float(w.x << 16); a[1] = __uint_as_float(w.x & 0xffff0000u); a[2] = __uint_as_float(w.y << 16); a[3] = __uint_as_float(w.y & 0xffff0000u);
    b[0] = __uint_as_float(w.z << 16); b[1] = __uint_as_float(w.z & 0xffff0000u); b[2] = __uint_as_float(w.w << 16); b[3] = __uint_as_float(w.w & 0xffff0000u); }
__device__ __forceinline__ void rope8(f32x4& a, f32x4& b, const float* tab) {
    const f32x4 t0 = *(const f32x4*)tab, t1 = *(const f32x4*)(tab + 4);
    float x1, x2;
    x1 = a[0]; x2 = a[1]; a[0] = x1 * t0[0] - x2 * t0[1]; a[1] = x1 * t0[1] + x2 * t0[0];
    x1 = a[2]; x2 = a[3]; a[2] = x1 * t0[2] - x2 * t0[3]; a[3] = x1 * t0[3] + x2 * t0[2];
    x1 = b[0]; x2 = b[1]; b[0] = x1 * t1[0] - x2 * t1[1]; b[1] = x1 * t1[1] + x2 * t1[0];
    x1 = b[2]; x2 = b[3]; b[2] = x1 * t1[2] - x2 * t1[3]; b[3] = x1 * t1[3] + x2 * t1[2];
}
__device__ __forceinline__ void rope8v(f32x4& a, f32x4& b, const f32x4 t0, const f32x4 t1) {
    float x1, x2;
    x1 = a[0]; x2 = a[1]; a[0] = x1 * t0[0] - x2 * t0[1]; a[1] = x1 * t0[1] + x2 * t0[0];
    x1 = a[2]; x2 = a[3]; a[2] = x1 * t0[2] - x2 * t0[3]; a[3] = x1 * t0[3] + x2 * t0[2];
    x1 = b[0]; x2 = b[1]; b[0] = x1 * t1[0] - x2 * t1[1]; b[1] = x1 * t1[1] + x2 * t1[0];
    x1 = b[2]; x2 = b[3]; b[2] = x1 * t1[2] - x2 * t1[3]; b[3] = x1 * t1[3] + x2 * t1[2];
}
__device__ __forceinline__ float sigm(float v) { return __builtin_amdgcn_rcpf(1.f + __expf(-v)); }
__device__ __forceinline__ float sumsq8(f32x4 a, f32x4 b) { return (a[0] * a[0] + a[1] * a[1]) + (a[2] * a[2] + a[3] * a[3]) + (b[0] * b[0] + b[1] * b[1]) + (b[2] * b[2] + b[3] * b[3]); }
__device__ __forceinline__ void ssq_commit(float* p, float s, int fq) { s += __shfl_xor(s, 16); s += __shfl_xor(s, 32); if (fq == 0) *p = s; }
template <int NS> __device__ __forceinline__ float ssq_sum(const float* p) { float s = 0.f;
#pragma unroll
    for (int i = 0; i < NS / 4; ++i) { const f32x4 v = *(const f32x4*)(p + 4 * i); s += (v[0] + v[1]) + (v[2] + v[3]); } return s; }

template <int NS> __device__ __forceinline__ float ssq_sum_sh(const float* p, int fq) {
    float s;
    if (NS == 32) { const f32x4 a = *(const f32x4*)(p + 8 * fq), b = *(const f32x4*)(p + 8 * fq + 4); s = ((a[0] + a[1]) + (a[2] + a[3])) + ((b[0] + b[1]) + (b[2] + b[3])); }
    else if (NS == 8) { s = p[2 * fq] + p[2 * fq + 1]; }
    else { s = p[fq]; }
    s += __shfl_xor(s, 16); s += __shfl_xor(s, 32); return s;
}
__device__ __forceinline__ size_t sh_base(int pm, int s, int wr, int fr) { return ((((size_t)pm * 32 + s) * 2 + wr) * 16 + fr) * 8; }
__device__ __forceinline__ void sh_commit8(float* SH, int pm, int s, int wr, int fr, int fq, float (&ss)[8]) {
#pragma unroll
    for (int k = 0; k < 8; ++k) { ss[k] += __shfl_xor(ss[k], 16); ss[k] += __shfl_xor(ss[k], 32); }
    if (fq == 0) { float* p = SH + sh_base(pm, s, wr, fr); *(f32x4*)p = (f32x4){ss[0], ss[1], ss[2], ss[3]}; *(f32x4*)(p + 4) = (f32x4){ss[4], ss[5], ss[6], ss[7]}; }
}
template <bool FENCED> __device__ __forceinline__ void sh_sum8(const float* SH, int pm, int wr, int fr, int fq, float (&o8)[8]) {
    f32x4 a = {0.f, 0.f, 0.f, 0.f}, b = {0.f, 0.f, 0.f, 0.f};
#pragma unroll
    for (int j = 0; j < 8; ++j) { const float* p = SH + sh_base(pm, 8 * fq + j, wr, fr); a += *(const f32x4*)p; b += *(const f32x4*)(p + 4);
        if (FENCED && (j & 1) == 1) asm volatile("" : "+v"(a), "+v"(b) :: "memory"); }
#pragma unroll
    for (int k = 0; k < 4; ++k) { o8[k] = a[k]; o8[4 + k] = b[k]; }
#pragma unroll
    for (int k = 0; k < 8; ++k) { o8[k] += __shfl_xor(o8[k], 16); o8[k] += __shfl_xor(o8[k], 32); }
}
struct Epi {
    static constexpr bool PERM = true, AFTER_DRAIN = false;
    int mode;
    bf16_t *CQ, *CKV, *KR, *FQKV, *GATES, *QM, *KN, *VM, *MIX, *TMP, *H1B, *U;
    float *FF, *SQ, *SKV, *SH1, *SH2, *OUT; const float* X; const float* ROPE; const float* GN; unsigned* PCNT; int fuse8;
    __device__ __forceinline__ void operator()(f32x4 (&acc)[2][2][4][2], const Unit& u, int wr, int wc, int fr, int fq) const {
        const int rowb = u.pm * BM + wr * 64 + fr, colb = u.pn * BM + wc * 32 + 8 * fq;
        constexpr size_t MR = (size_t)MROWS; (void)MR;
#define ROWOF(ai, m) ((size_t)(rowb + (ai) * HALF + (m) * 16))
        if (mode == EM_PROJ) {
            const int pn = u.pn;
#pragma unroll
            for (int ai = 0; ai < 2; ++ai)
#pragma unroll
                for (int m = 0; m < 4; ++m) { const size_t rw = ROWOF(ai, m); const int row = (int)rw;
                    if (pn < 3) { float ss = 0.f;
#pragma unroll
                        for (int bj = 0; bj < 2; ++bj) { const int col = colb + bj * HALF; const f32x4 v0 = acc[ai][bj][m][0], v1 = acc[ai][bj][m][1]; ss += sumsq8(v0, v1);
                            if (pn < 2) *(u32x4*)(CQ + rw * 512 + col) = pack8(v0, v1); else *(u32x4*)(CKV + rw * 256 + (col - 512)) = pack8(v0, v1); }
                        if (pn < 2) ssq_commit(SQ + rw * 8 + pn * 4 + wc, ss, fq); else ssq_commit(SKV + rw * 4 + wc, ss, fq);
                    } else if (pn == 3) {
                        const int lc = wc * 32 + 8 * fq;
                        if (lc < 64) { if (m == 0) {
                                f32x4 tb[4][2];
#pragma unroll
                                for (int mm = 0; mm < 4; ++mm) { const float* tp = ROPE + ((ROWOF(ai, mm) & (size_t)(SEQ - 1)) * 32 + (size_t)(lc >> 1)) * 2; tb[mm][0] = *(const f32x4*)tp; tb[mm][1] = *(const f32x4*)(tp + 4); }
#pragma unroll
                                for (int mm = 0; mm < 4; ++mm) { f32x4 v0 = acc[ai][0][mm][0], v1 = acc[ai][0][mm][1]; rope8v(v0, v1, tb[mm][0], tb[mm][1]); *(u32x4*)(KR + ROWOF(ai, mm) * 64 + lc) = pack8(v0, v1); } } }
                        else if (lc == 64) { *(f32x4*)(FF + rw * 8) = acc[ai][0][m][0]; *(f32x4*)(FF + rw * 8 + 4) = acc[ai][0][m][1]; }
                    } else if (pn < 16) {
                        const int t = (pn - 4) >> 2;
#pragma unroll
                        for (int bj = 0; bj < 2; ++bj) { const int col = colb + bj * HALF - 1024 - t * 1024; *(u32x4*)(FQKV + (size_t)t * MR * 1024 + rw * 1024 + col) = pack8(acc[ai][bj][m][0], acc[ai][bj][m][1]); }
                    } else {
#pragma unroll
                        for (int bj = 0; bj < 2; ++bj) { const int col = colb + bj * HALF - 4096; f32x4 v0 = acc[ai][bj][m][0], v1 = acc[ai][bj][m][1];
#pragma unroll
                            for (int i = 0; i < 4; ++i) { v0[i] = sigm(v0[i]); v1[i] = sigm(v1[i]); }
                            *(u32x4*)(GATES + rw * 4096 + col) = pack8(v0, v1); }
                    }
                }
        } else if (mode == EM_QUP || mode == EM_KVUP || mode == EM_UP) {
            float rsv[2][4];
            if (mode == EM_UP) { float t8[8]; sh_sum8<false>(SH1, u.pm, wr, fr, fq, t8);
#pragma unroll
                for (int k = 0; k < 8; ++k) rsv[k >> 2][k & 3] = t8[k] * (1.f / 2048.f); }
            else {
#pragma unroll
                for (int ai = 0; ai < 2; ++ai)
#pragma unroll
                    for (int m = 0; m < 4; ++m) { const size_t rw = ROWOF(ai, m);
                        rsv[ai][m] = mode == EM_QUP ? ssq_sum_sh<8>(SQ + rw * 8, fq) * (1.f / 512.f) : ssq_sum_sh<4>(SKV + rw * 4, fq) * (1.f / 256.f); } }
#pragma unroll
            for (int ai = 0; ai < 2; ++ai)
#pragma unroll
                for (int m = 0; m < 4; ++m) rsv[ai][m] = rsqrtf(rsv[ai][m] + EPS);
            if (mode == EM_QUP) {
                const int g0 = (u.pn * 8 + wc) % 6, g1 = (u.pn * 8 + 4 + wc) % 6;
#pragma unroll
                for (int am = 0; am < 4; ++am) { const int ai = am >> 1, mb = (am & 1) * 2;
                    f32x4 tb[4][2][2];
#pragma unroll
                    for (int m = mb; m < mb + 2; ++m)
#pragma unroll
                        for (int bj = 0; bj < 2; ++bj) { const int g = bj ? g1 : g0;
                            if (g >= 4) { const float* tp = ROPE + ((ROWOF(ai, m) & (size_t)(SEQ - 1)) * 32 + (size_t)(((g - 4) * 32 + 8 * fq) >> 1)) * 2; tb[m][bj][0] = *(const f32x4*)tp; tb[m][bj][1] = *(const f32x4*)(tp + 4); } }
#pragma unroll
                    for (int m = mb; m < mb + 2; ++m) { const size_t rw = ROWOF(ai, m); const float rs = rsv[ai][m];
#pragma unroll
                        for (int bj = 0; bj < 2; ++bj) { const int col = colb + bj * HALF, g = bj ? g1 : g0; f32x4 v0 = acc[ai][bj][m][0] * rs, v1 = acc[ai][bj][m][1] * rs;
                            if (g >= 4) rope8v(v0, v1, tb[m][bj][0], tb[m][bj][1]);
                            *(u32x4*)(QM + rw * 1536 + col) = pack8(v0, v1); } }
                }
            } else if (mode == EM_KVUP) {
#pragma unroll
                for (int ai = 0; ai < 2; ++ai)
#pragma unroll
                    for (int m = 0; m < 4; ++m) { const size_t rw = ROWOF(ai, m); const float rs = rsv[ai][m];
#pragma unroll
                        for (int bj = 0; bj < 2; ++bj) { const int col = colb + bj * HALF; const f32x4 v0 = acc[ai][bj][m][0] * rs, v1 = acc[ai][bj][m][1] * rs;
                            if (u.pn < 4) *(u32x4*)(KN + rw * 1024 + col) = pack8(v0, v1); else *(u32x4*)(VM + rw * 1024 + (col - 1024)) = pack8(v0, v1); } }
            } else {
#pragma unroll
                for (int ai = 0; ai < 2; ++ai)
#pragma unroll
                    for (int m = 0; m < 4; ++m) { const size_t rw = ROWOF(ai, m); const float rs = rsv[ai][m];
#pragma unroll
                        for (int bj = 0; bj < 2; ++bj) { const int col = colb + bj * HALF; f32x4 v0 = acc[ai][bj][m][0], v1 = acc[ai][bj][m][1];
#pragma unroll
                            for (int i = 0; i < 4; ++i) { float a = fmaxf(v0[i], 0.f) * rs, b = fmaxf(v1[i], 0.f) * rs; v0[i] = a * a; v1[i] = b * b; }
                            *(u32x4*)(U + rw * 8192 + col) = pack8(v0, v1); } }
            }
        } else if (mode == EM_BR1) {
            u32x4 gt[2][4][2];
#pragma unroll
            for (int ai = 0; ai < 2; ++ai)
#pragma unroll
                for (int m = 0; m < 4; ++m)
#pragma unroll
                    for (int bj = 0; bj < 2; ++bj) gt[ai][m][bj] = *(const u32x4*)(GATES + ROWOF(ai, m) * 4096 + colb + bj * HALF);
#pragma unroll
            for (int ai = 0; ai < 2; ++ai)
#pragma unroll
                for (int m = 0; m < 4; ++m)
#pragma unroll
                    for (int bj = 0; bj < 2; ++bj) { f32x4 g0, g1; unpack8(gt[ai][m][bj], g0, g1);
                        *(u32x4*)(TMP + ROWOF(ai, m) * 2048 + colb + bj * HALF) = pack8(acc[ai][bj][m][0] * g0, acc[ai][bj][m][1] * g1); }
        } else if (mode == EM_BR2) {
#pragma unroll
            for (int ai = 0; ai < 2; ++ai) {
                u32x4 gt[4][2], tt[4][2];
#pragma unroll
                for (int m = 0; m < 4; ++m)
#pragma unroll
                    for (int bj = 0; bj < 2; ++bj) { gt[m][bj] = *(const u32x4*)(GATES + ROWOF(ai, m) * 4096 + 2048 + colb + bj * HALF); tt[m][bj] = *(const u32x4*)(TMP + ROWOF(ai, m) * 2048 + colb + bj * HALF); }
#pragma unroll
                for (int m = 0; m < 4; ++m)
#pragma unroll
                    for (int bj = 0; bj < 2; ++bj) { f32x4 g0, g1, t0, t1; unpack8(gt[m][bj], g0, g1); unpack8(tt[m][bj], t0, t1);
                        *(u32x4*)(MIX + ROWOF(ai, m) * 2048 + colb + bj * HALF) = pack8(t0 + acc[ai][bj][m][0] * g0, t1 + acc[ai][bj][m][1] * g1); }
            }
        } else if (mode == EM_DOWN && !fuse8) {
#pragma unroll
            for (int ai = 0; ai < 2; ++ai)
#pragma unroll
                for (int m = 0; m < 4; ++m) { const size_t rw = ROWOF(ai, m); float ss = 0.f;
#pragma unroll
                    for (int bj = 0; bj < 2; ++bj) { const size_t o = rw * 2048 + colb + bj * HALF; f32x4 r0, r1; unpack8(*(const u32x4*)(H1B + o), r0, r1); const f32x4 h0 = r0 + acc[ai][bj][m][0], h1 = r1 + acc[ai][bj][m][1];
                        *(f32x4*)(OUT + o) = h0; *(f32x4*)(OUT + o + 4) = h1; ss += sumsq8(h0, h1); }
                    ss += __shfl_xor(ss, 16); ss += __shfl_xor(ss, 32); if (fq == 0) SH2[sh_base(u.pm, u.pn * 4 + wc, wr, fr) + ai * 4 + m] = ss; }
        } else if (mode == EM_OUT) { float ss8[8];
            const float* RES = X;
#pragma unroll
            for (int ai = 0; ai < 2; ++ai) {
                f32x4 xin[4][2][2];
#pragma unroll
                for (int m = 0; m < 4; ++m)
#pragma unroll
                    for (int bj = 0; bj < 2; ++bj) { const size_t o = ROWOF(ai, m) * 2048 + colb + bj * HALF; xin[m][bj][0] = *(const f32x4*)(RES + o); xin[m][bj][1] = *(const f32x4*)(RES + o + 4); }
#pragma unroll
                for (int m = 0; m < 4; ++m) { const size_t rw = ROWOF(ai, m); float ss = 0.f;
#pragma unroll
                    for (int bj = 0; bj < 2; ++bj) { const size_t o = rw * 2048 + colb + bj * HALF; const f32x4 h0 = xin[m][bj][0] + acc[ai][bj][m][0], h1 = xin[m][bj][1] + acc[ai][bj][m][1];
                        *(u32x4*)(H1B + o) = pack8(h0, h1); ss += sumsq8(h0, h1); }
                    ss8[ai * 4 + m] = ss; }
            }
            sh_commit8(SH1, u.pm, u.pn * 4 + wc, wr, fr, fq, ss8);
        } else { float ss8[8];
#pragma unroll
            for (int am = 0; am < 4; ++am) { const int ai = am >> 1, mb = (am & 1) * 2;
                u32x4 xin[2][2];
#pragma unroll
                for (int m2 = 0; m2 < 2; ++m2)
#pragma unroll
                    for (int bj = 0; bj < 2; ++bj) xin[m2][bj] = *(const u32x4*)(H1B + ROWOF(ai, mb + m2) * 2048 + colb + bj * HALF);
#pragma unroll
                for (int m2 = 0; m2 < 2; ++m2) { const int m = mb + m2; float ss = 0.f;
#pragma unroll
                    for (int bj = 0; bj < 2; ++bj) { f32x4 r0, r1; unpack8(xin[m2][bj], r0, r1); acc[ai][bj][m][0] += r0; acc[ai][bj][m][1] += r1; ss += sumsq8(acc[ai][bj][m][0], acc[ai][bj][m][1]); }
                    ss8[ai * 4 + m] = ss; }
                asm volatile("" ::: "memory"); }
            sh_commit8(SH2, u.pm, u.pn * 4 + wc, wr, fr, fq, ss8);
            asm volatile("s_waitcnt vmcnt(0)" ::: "memory");
            unsigned* c = PCNT + 64 * u.pm;
            if (fr == 0 && fq == 0) __hip_atomic_fetch_add(c, 1u, __ATOMIC_RELAXED, __HIP_MEMORY_SCOPE_AGENT);
            { unsigned sp = 0u; while (__hip_atomic_load(c, __ATOMIC_RELAXED, __HIP_MEMORY_SCOPE_AGENT) < 64u) { __builtin_amdgcn_s_sleep(1); if (++sp > (1u << 24)) break; } }
            __builtin_amdgcn_fence(__ATOMIC_ACQUIRE, "agent"); asm volatile("s_waitcnt vmcnt(0)" ::: "memory");
            float t8[8]; sh_sum8<true>(SH2, u.pm, wr, fr, fq, t8);
            f32x4 gv[2][2];
#pragma unroll
            for (int bj = 0; bj < 2; ++bj) { gv[bj][0] = *(const f32x4*)(GN + colb + bj * HALF); gv[bj][1] = *(const f32x4*)(GN + colb + bj * HALF + 4); }
#pragma unroll
            for (int ai = 0; ai < 2; ++ai)
#pragma unroll
                for (int m = 0; m < 4; ++m) { const size_t rw = ROWOF(ai, m); const float rs = rsqrtf(t8[ai * 4 + m] * (1.f / 2048.f) + EPS);
#pragma unroll
                    for (int bj = 0; bj < 2; ++bj) { const size_t o = rw * 2048 + colb + bj * HALF;
                        *(f32x4*)(OUT + o) = acc[ai][bj][m][0] * rs * gv[bj][0]; *(f32x4*)(OUT + o + 4) = acc[ai][bj][m][1] * rs * gv[bj][1]; } }
        }
#undef ROWOF
    }
};
template <class Epi, class Sched, bool ALIGN_EPI = false, bool SP2 = false>
__device__ __forceinline__ void gemm_phase(PG8_LAS unsigned char* lds, const Gemm g, const Sched& S, const Epi& E) {
    int tid_ = threadIdx.x; asm volatile("" : "+v"(tid_));
    const int tid = tid_, wid = __builtin_amdgcn_readfirstlane(tid >> 6), lane = tid & 63, wr = wid >> 2, wc = wid & 3, fr = lane & 15, fq = lane >> 4;
    const int K = g.K, nt = K / BK;
    unsigned voffA[2], voffB[2];
#pragma unroll
    for (int i = 0; i < 2; ++i) { int R, C; stage_rc(tid * 16 + i * 8192, R, C); const int Rb = Epi::PERM ? ((R & ~31) + perm32(R & 31)) : R;
        voffA[i] = (unsigned)(R * K + C) * 2u; voffB[i] = (unsigned)(Rb * K + C) * 2u; }
    const size_t kstep = (size_t)(BK * 2);
    const size_t hstep = (size_t)HALF * K * 2;
    const size_t tstep = 2 * hstep;
    const unsigned ldsw = (unsigned)wid * 1024u;
    const int aoff = lds_byte(wr * 64 + fr, fq * 8), boff = lds_byte(wc * 32 + fr, fq * 8);
#define PG8_SA(b, h) (((b) * 2 + (h)) * HTB)
#define PG8_SB(b, h) ((4 + (b) * 2 + (h)) * HTB)
#define PG8_STAGE(bufoff, gbase, voff) do { _Pragma("unroll") for (int _i = 0; _i < 2; ++_i) \
        __builtin_amdgcn_global_load_lds((const unsigned*)((const char*)(gbase) + (voff)[_i]), (PG8_LAS unsigned*)(lds + (bufoff) + ldsw + _i * 8192), 16, 0, 0); } while (0)
#define PG8_LDA(dst, b, h) do { _Pragma("unroll") for (int m = 0; m < 4; ++m) _Pragma("unroll") for (int k = 0; k < 2; ++k) dst[m][k] = *(const PG8_LAS bf16x8*)(lds + PG8_SA(b, h) + aoff + m * 2048 + k * 1024); } while (0)
#define PG8_LDB(dst, b, h) do { _Pragma("unroll") for (int n = 0; n < 2; ++n) _Pragma("unroll") for (int k = 0; k < 2; ++k) dst[n][k] = *(const PG8_LAS bf16x8*)(lds + PG8_SB(b, h) + boff + n * 2048 + k * 1024); } while (0)
#define PG8_MMA(ai, bj, At, Bt) do { __builtin_amdgcn_s_setprio(1); _Pragma("unroll") for (int m = 0; m < 4; ++m) _Pragma("unroll") for (int n = 0; n < 2; ++n) _Pragma("unroll") for (int k = 0; k < 2; ++k) \
        acc[ai][bj][m][n] = __builtin_amdgcn_mfma_f32_16x16x32_bf16(Bt[n][k], At[m][k], acc[ai][bj][m][n], 0, 0, 0); __builtin_amdgcn_s_setprio(0); } while (0)
#define PG8_WAIT_V(n) asm volatile("s_waitcnt vmcnt(" #n ")" ::: "memory")
#define PG8_WAIT_L(n) asm volatile("s_waitcnt lgkmcnt(" #n ")" ::: "memory")
#define PG8_BAR __builtin_amdgcn_s_barrier()
#define PG8_SCHED __builtin_amdgcn_sched_barrier(0)
    Unit cur, nxt; int ui = 0;
    if (!S.next(0, cur)) return;
    f32x4 acc[2][2][4][2];
#pragma unroll
    for (int a = 0; a < 2; ++a)
#pragma unroll
        for (int b = 0; b < 2; ++b)
#pragma unroll
            for (int m = 0; m < 4; ++m)
#pragma unroll
                for (int n = 0; n < 2; ++n) acc[a][b][m][n] = (f32x4){0.f, 0.f, 0.f, 0.f};
    bf16x8 At[4][2], B0[2][2], B1[2][2];
    const char* cA = (const char*)g.A + (size_t)cur.pm * tstep; const char* cB = (const char*)g.Bt + (size_t)cur.pn * tstep;
    S.a_ready(cur);
    if constexpr (SP2) {
        PG8_STAGE(PG8_SB(0, 0), cB, voffB); PG8_STAGE(PG8_SB(0, 1), cB + hstep, voffB); PG8_STAGE(PG8_SA(0, 0), cA, voffA); PG8_STAGE(PG8_SA(0, 1), cA + hstep, voffA);
        if (wr == 1) PG8_BAR;
        PG8_WAIT_V(2); PG8_BAR;
        PG8_STAGE(PG8_SB(1, 0), cB + kstep, voffB); PG8_STAGE(PG8_SA(1, 0), cA + kstep, voffA); PG8_STAGE(PG8_SB(1, 1), cB + hstep + kstep, voffB);
        PG8_WAIT_V(6); PG8_BAR;
    } else {
        PG8_STAGE(PG8_SB(0, 0), cB, voffB); PG8_STAGE(PG8_SA(0, 0), cA, voffA); PG8_STAGE(PG8_SB(0, 1), cB + hstep, voffB); PG8_STAGE(PG8_SA(0, 1), cA + hstep, voffA);
        if (wr == 1) PG8_BAR;
        PG8_WAIT_V(4); PG8_BAR;
        PG8_STAGE(PG8_SB(1, 0), cB + kstep, voffB); PG8_STAGE(PG8_SA(1, 0), cA + kstep, voffA); PG8_STAGE(PG8_SB(1, 1), cB + hstep + kstep, voffB);
        PG8_WAIT_V(6); PG8_BAR;
    }
    for (;;) {
        const bool has_next = S.next(ui + 1, nxt);
        const char* nA = has_next ? (const char*)g.A + (size_t)nxt.pm * tstep : cA; const char* nB = has_next ? (const char*)g.Bt + (size_t)nxt.pn * tstep : cB;
        for (int t = 0; t < nt; t += 2) {
            const bool last = (t == nt - 2);
            const char* a1 = cA + (size_t)(t + 1) * kstep;
            const char* a2 = last ? nA : cA + (size_t)(t + 2) * kstep; const char* b2 = last ? nB : cB + (size_t)(t + 2) * kstep;
            const char* a3 = a2 + kstep; const char* b3 = b2 + kstep;
            if (last && has_next) S.a_ready(nxt);
            if constexpr (SP2) {
            PG8_LDB(B0, 0, 0); PG8_LDB(B1, 0, 1); PG8_SCHED; PG8_LDA(At, 0, 0); PG8_STAGE(PG8_SA(1, 1), a1 + hstep, voffA);
            PG8_WAIT_V(8); PG8_WAIT_L(0); PG8_BAR; PG8_MMA(0, 0, At, B0); PG8_MMA(0, 1, At, B1); PG8_BAR; PG8_SCHED;
            PG8_LDA(At, 0, 1); PG8_STAGE(PG8_SB(0, 0), b2, voffB); PG8_STAGE(PG8_SB(0, 1), b2 + hstep, voffB); PG8_STAGE(PG8_SA(0, 0), a2, voffA);
            PG8_WAIT_V(8); PG8_WAIT_L(0); PG8_BAR; PG8_MMA(1, 0, At, B0); PG8_MMA(1, 1, At, B1); PG8_BAR; PG8_SCHED;
            PG8_LDB(B0, 1, 0); PG8_LDB(B1, 1, 1); PG8_SCHED; PG8_LDA(At, 1, 0); PG8_STAGE(PG8_SA(0, 1), a2 + hstep, voffA);
            PG8_WAIT_V(8); PG8_WAIT_L(0); PG8_BAR; PG8_MMA(0, 0, At, B0); PG8_MMA(0, 1, At, B1); PG8_BAR; PG8_SCHED;
            PG8_LDA(At, 1, 1); PG8_STAGE(PG8_SB(1, 0), b3, voffB); PG8_STAGE(PG8_SB(1, 1), b3 + hstep, voffB); PG8_STAGE(PG8_SA(1, 0), a3, voffA);
            PG8_WAIT_V(8); PG8_WAIT_L(0); PG8_BAR; PG8_MMA(1, 0, At, B0); PG8_MMA(1, 1, At, B1); PG8_BAR; PG8_SCHED;
            } else {
            PG8_LDB(B0, 0, 0); PG8_SCHED; PG8_LDA(At, 0, 0); PG8_STAGE(PG8_SA(1, 1), a1 + hstep, voffA);
            PG8_WAIT_L(8); PG8_BAR; PG8_WAIT_L(0); PG8_MMA(0, 0, At, B0); PG8_BAR; PG8_SCHED;
            PG8_LDB(B1, 0, 1); PG8_STAGE(PG8_SB(0, 0), b2, voffB);
            PG8_BAR; PG8_WAIT_L(0); PG8_MMA(0, 1, At, B1); PG8_BAR;
            PG8_LDA(At, 0, 1); PG8_STAGE(PG8_SA(0, 0), a2, voffA);
            PG8_BAR; PG8_WAIT_L(0); PG8_MMA(1, 0, At, B0); PG8_BAR; PG8_SCHED;
            PG8_STAGE(PG8_SB(0, 1), b2 + hstep, voffB);
            PG8_WAIT_V(6); PG8_BAR; PG8_MMA(1, 1, At, B1); PG8_BAR;
            PG8_LDB(B0, 1, 0); PG8_SCHED; PG8_LDA(At, 1, 0); PG8_STAGE(PG8_SA(0, 1), a2 + hstep, voffA);
            PG8_WAIT_L(8); PG8_BAR; PG8_WAIT_L(0); PG8_MMA(0, 0, At, B0); PG8_BAR; PG8_SCHED;
            PG8_LDB(B1, 1, 1); PG8_STAGE(PG8_SB(1, 0), b3, voffB);
            PG8_BAR; PG8_WAIT_L(0); PG8_MMA(0, 1, At, B1); PG8_BAR;
            PG8_LDA(At, 1, 1); PG8_STAGE(PG8_SA(1, 0), a3, voffA);
            PG8_BAR; PG8_WAIT_L(0); PG8_MMA(1, 0, At, B0); PG8_BAR; PG8_SCHED;
            PG8_STAGE(PG8_SB(1, 1), b3 + hstep, voffB);
            PG8_WAIT_V(6); PG8_BAR; PG8_MMA(1, 1, At, B1); PG8_BAR;
            }
        }
        if constexpr (ALIGN_EPI) { if (wr == 0) PG8_BAR; }
        if constexpr (!Epi::AFTER_DRAIN) { E(acc, cur, wr, wc, fr, fq); S.done(cur); }
        if (!has_next) break;
#pragma unroll
        for (int a = 0; a < 2; ++a)
#pragma unroll
            for (int b = 0; b < 2; ++b)
#pragma unroll
                for (int m = 0; m < 4; ++m)
#pragma unroll
                    for (int n = 0; n < 2; ++n) acc[a][b][m][n] = (f32x4){0.f, 0.f, 0.f, 0.f};
        cur = nxt; cA = nA; cB = nB; ++ui;
        if constexpr (ALIGN_EPI) { if (wr == 1) PG8_BAR; }
    }
    PG8_WAIT_V(0);
    if constexpr (!ALIGN_EPI) { if (wr == 0) PG8_BAR; }
    PG8_BAR;
    if constexpr (Epi::AFTER_DRAIN) { E.fused(acc, cur, wr, wc, fr, fq, lds, wid, lane); S.done(cur); }
#undef PG8_SA
#undef PG8_SB
#undef PG8_STAGE
#undef PG8_LDA
#undef PG8_LDB
#undef PG8_MMA
#undef PG8_WAIT_V
#undef PG8_WAIT_L
#undef PG8_BAR
#undef PG8_SCHED
}
}
#ifndef ATT_PIPE_FOX
#define ATT_PIPE_FOX 0
#endif
#ifndef ATT_PIPE_MLA
#define ATT_PIPE_MLA 0
#endif
namespace att {
using bf16 = __hip_bfloat16;
typedef short bf16x8 __attribute__((ext_vector_type(8)));
typedef short s16x4 __attribute__((ext_vector_type(4)));
typedef float f32x16 __attribute__((ext_vector_type(16)));
typedef float f32x4 __attribute__((ext_vector_type(4)));
typedef unsigned u32x4 __attribute__((ext_vector_type(4)));
constexpr int D = 128, NW = 8, QBLK = 32, KVBLK = 64, QB = NW * QBLK, LDKV = 1024, LDO = 1024;
constexpr int SHM_V = KVBLK * D * 2, SHM_K = KVBLK * D * 2, SHM_KR = KVBLK * 64 * 2;
constexpr int OFF_V = 0, OFF_K = 2 * SHM_V, OFF_KR = OFF_K + 2 * SHM_K, OFF_WS = OFF_KR + 2 * SHM_KR, OFF_BIAS = OFF_WS + NW * 64 * 4, LDS_BYTES = OFF_BIAS + 2 * 64 * 4;
constexpr float THR = 8.f;
template <int MODE> struct Cfg { static constexpr float SCALE = MODE ? 0.07216878364870322f : 0.08838834764831845f; static constexpr int QLD = MODE ? 1536 : 1024, NQ = MODE ? 12 : 8; };

#define KSWZ(row, colB) ((row) * 256 + ((colB) ^ (((row) & 7) << 4)))
#define SBAR() __builtin_amdgcn_sched_barrier(0)
__device__ __forceinline__ int v_st(int k, int c) { const int kk = (k & ~0xC) | ((k & 4) << 1) | ((k & 8) >> 1); return ((kk >> 3) * 4 + (c >> 5)) * 512 + ((kk & 7) * 32 + (c & 31)) * 2; }
__device__ __forceinline__ int v_rd_base(int lane) { return ((lane & 3) << 3) | (((lane >> 2) & 3) << 6) | (((lane >> 4) & 1) << 5) | (((lane >> 5) & 1) << 8); }
constexpr int v_rd_off(int d0, int ks, int half) { return d0 * 512 + ks * 4096 + half * 2048; }
__device__ __forceinline__ int crow(int r, int hi) { return (r & 3) + 8 * (r >> 2) + 4 * hi; }
__device__ __forceinline__ unsigned cvtpk(float lo, float hi) { unsigned r; asm volatile("v_cvt_pk_bf16_f32 %0, %1, %2" : "=v"(r) : "v"(lo), "v"(hi)); return r; }
__device__ __forceinline__ bf16x8 ld8(const bf16* p) { return *reinterpret_cast<const bf16x8*>(p); }
__device__ __forceinline__ void mask_tile(f32x16& p0, f32x16& p1, int dq) {
    const float NEG = -__builtin_inff();
#pragma unroll
    for (int r = 0; r < 16; ++r) { const int c = (r & 3) + 8 * (r >> 2); if (dq - c < 0) p0[r] = NEG; if (dq - c - 32 < 0) p1[r] = NEG; }
}
template <int MODE>
__device__ __forceinline__ void partialSM(f32x16& p0, f32x16& p1, float& m_reg, float& mn, float& alpha) {
    constexpr float SCALE = Cfg<MODE>::SCALE;
    float pmax = p0[0]; for (int r = 1; r < 16; ++r) pmax = fmaxf(pmax, p0[r]); for (int r = 0; r < 16; ++r) pmax = fmaxf(pmax, p1[r]);
    { auto rr = __builtin_amdgcn_permlane32_swap(__float_as_uint(pmax), __float_as_uint(pmax), false, false);
      pmax = fmaxf(__uint_as_float(rr[0]), __uint_as_float(rr[1])); }
    constexpr float C2 = 1.4426950408889634f * SCALE;
    if (__builtin_expect(__all((pmax - m_reg) * SCALE <= THR), 1)) { mn = m_reg; alpha = 1.f; }
    else { mn = fmaxf(m_reg, pmax); alpha = __builtin_amdgcn_exp2f((m_reg - mn) * C2); m_reg = mn; }
    const float mnL = -mn * C2;
    for (int r = 0; r < 16; ++r) p0[r] = fmaf(p0[r], C2, mnL); for (int r = 0; r < 16; ++r) p1[r] = fmaf(p1[r], C2, mnL);
    for (int r = 0; r < 16; ++r) p0[r] = __builtin_amdgcn_exp2f(p0[r]);
}
__device__ __forceinline__ void finishSM(f32x16& p0, f32x16& p1, float alpha, float& l_reg, bf16x8& pa0, bf16x8& pa1, bf16x8& pa2, bf16x8& pa3) {
    for (int r = 0; r < 16; ++r) p1[r] = __builtin_amdgcn_exp2f(p1[r]);
    float ps = 0; for (int r = 0; r < 16; ++r) ps += p0[r]; for (int r = 0; r < 16; ++r) ps += p1[r];
    { auto rr = __builtin_amdgcn_permlane32_swap(__float_as_uint(ps), __float_as_uint(ps), false, false);
      ps = __uint_as_float(rr[0]) + __uint_as_float(rr[1]); }
    l_reg = l_reg * alpha + ps;
#define PK4(P, B_, OUT) do { unsigned a0 = cvtpk(P[B_+0], P[B_+1]), a1 = cvtpk(P[B_+2], P[B_+3]);                          \
        unsigned b0 = cvtpk(P[B_+4], P[B_+5]), b1 = cvtpk(P[B_+6], P[B_+7]);                                             \
        auto r0 = __builtin_amdgcn_permlane32_swap(a0, b0, false, false); auto r1 = __builtin_amdgcn_permlane32_swap(a1, b1, false, false); \
        u32x4 w = {r0[0], r1[0], r0[1], r1[1]}; OUT = *reinterpret_cast<bf16x8*>(&w); } while (0)
    PK4(p0, 0, pa0); PK4(p0, 8, pa1); PK4(p1, 0, pa2); PK4(p1, 8, pa3);
#undef PK4
}
template <int KB, int MODE>
__device__ __forceinline__ void qkt(f32x16& p0, f32x16& p1, const char* lds, int r32, int hi, const bf16x8* qr, bool act) {
    if (MODE == 1 && !act) { const float NEG = -__builtin_inff();
#pragma unroll
        for (int r = 0; r < 16; ++r) { p0[r] = NEG; p1[r] = NEG; } return; }
    if (MODE == 0) { const float* bp = (const float*)(lds + OFF_BIAS) + KB * 64 + 4 * hi;
#pragma unroll
        for (int g = 0; g < 4; ++g) { const f32x4 a = *(const f32x4*)(bp + 8 * g), b = *(const f32x4*)(bp + 32 + 8 * g);
#pragma unroll
            for (int i = 0; i < 4; ++i) { p0[4 * g + i] = a[i]; p1[4 * g + i] = b[i]; } }
    } else { p0 = f32x16{}; p1 = f32x16{}; }
    int ko[4];
#pragma unroll
    for (int dd = 0; dd < 4; ++dd) ko[dd] = KSWZ(r32, (dd * 16 + hi * 8) * 2);
#pragma unroll
    for (int d0 = 0; d0 < 8; ++d0) { const char* a = lds + OFF_K + KB * SHM_K + ko[d0 & 3] + (d0 >> 2) * 128;
        bf16x8 b0 = *reinterpret_cast<const bf16x8*>(a);
        bf16x8 b1 = *reinterpret_cast<const bf16x8*>(a + 32 * 256);
        p0 = __builtin_amdgcn_mfma_f32_32x32x16_bf16(b0, qr[d0], p0, 0, 0, 0);
        p1 = __builtin_amdgcn_mfma_f32_32x32x16_bf16(b1, qr[d0], p1, 0, 0, 0);
        if ((d0 & 3) == 3) SBAR(); }
    if (MODE == 1) {
#pragma unroll
        for (int d0 = 0; d0 < 4; ++d0) { const char* a = lds + OFF_KR + KB * SHM_KR + ko[d0];
            bf16x8 b0 = *reinterpret_cast<const bf16x8*>(a);
            bf16x8 b1 = *reinterpret_cast<const bf16x8*>(a + 128);
            p0 = __builtin_amdgcn_mfma_f32_32x32x16_bf16(b0, qr[8 + d0], p0, 0, 0, 0);
            p1 = __builtin_amdgcn_mfma_f32_32x32x16_bf16(b1, qr[8 + d0], p1, 0, 0, 0); }
    }
}
template <int VB, bool SK>
__device__ __forceinline__ void pv_tile(f32x16* o, int vb0, bf16x8 pa0, bf16x8 pa1, bf16x8 pa2, bf16x8 pa3, bool act) {
    if (SK && !act) return;
#define TRRD(dst, off) asm volatile("ds_read_b64_tr_b16 %0, %1 offset:%2" : "=&v"(dst) : "v"(vb0), "i"(off) : "memory")
#define PV_D0(d0) do { s16x4 l0, l1, l2, l3, h0, h1, h2, h3; constexpr int b_ = VB * SHM_V + v_rd_off(d0, 0, 0); \
        TRRD(l0, b_); TRRD(h0, b_ + 2048); TRRD(l1, b_ + 4096); TRRD(h1, b_ + 6144); TRRD(l2, b_ + 8192); TRRD(h2, b_ + 10240); TRRD(l3, b_ + 12288); TRRD(h3, b_ + 14336); \
          \
        asm volatile("s_waitcnt lgkmcnt(6)" ::: "memory"); SBAR();   \
        o[d0] = __builtin_amdgcn_mfma_f32_32x32x16_bf16(pa0, (bf16x8){l0[0], l0[1], l0[2], l0[3], h0[0], h0[1], h0[2], h0[3]}, o[d0], 0, 0, 0); SBAR();  \
        asm volatile("s_waitcnt lgkmcnt(4)" ::: "memory"); SBAR();   \
        o[d0] = __builtin_amdgcn_mfma_f32_32x32x16_bf16(pa1, (bf16x8){l1[0], l1[1], l1[2], l1[3], h1[0], h1[1], h1[2], h1[3]}, o[d0], 0, 0, 0); SBAR();  \
        asm volatile("s_waitcnt lgkmcnt(2)" ::: "memory"); SBAR();   \
        o[d0] = __builtin_amdgcn_mfma_f32_32x32x16_bf16(pa2, (bf16x8){l2[0], l2[1], l2[2], l2[3], h2[0], h2[1], h2[2], h2[3]}, o[d0], 0, 0, 0); SBAR();  \
        asm volatile("s_waitcnt lgkmcnt(0)" ::: "memory"); SBAR();   \
        o[d0] = __builtin_amdgcn_mfma_f32_32x32x16_bf16(pa3, (bf16x8){l3[0], l3[1], l3[2], l3[3], h3[0], h3[1], h3[2], h3[3]}, o[d0], 0, 0, 0); } while (0)
    PV_D0(0); PV_D0(1); PV_D0(2); PV_D0(3);
#undef PV_D0
#undef TRRD
}

struct BlockRef { const bf16* Q; const bf16* K; const bf16* V; bf16* O; const bf16* KR; const float* BIAS; int P0; };
template <int MODE> struct Seam { bf16x8 qr[Cfg<MODE>::NQ]; bf16x8 st_v0, st_v1, st_k0, st_k1, st_kr; float st_b; };

#define ROWKV(p, k0, rr) ((p) + (size_t)((k0) + (rr)) * LDKV + sc)
#define VMW() asm volatile("s_waitcnt vmcnt(0)" ::: "memory")
#define VMWN(n) asm volatile("s_waitcnt vmcnt(%0)" :: "i"(n) : "memory")
#define SLOAD(R, k0) do { S.st_v0 = ld8(ROWKV((R).V, k0, sr)); S.st_v1 = ld8(ROWKV((R).V, k0, 32 + sr));              \
                          S.st_k0 = ld8(ROWKV((R).K, k0, sr)); S.st_k1 = ld8(ROWKV((R).K, k0, 32 + sr));              \
                          if (MODE == 1) S.st_kr = ld8((R).KR + (size_t)((k0) + (tid >> 3)) * 64 + (tid & 7) * 8);       \
                          if (MODE == 0) { if (tid < 64) S.st_b = (R).BIAS[(k0) + tid]; } } while (0)
#define SWRITE_K(bf) do { *(bf16x8*)(lds + OFF_K + (bf) * SHM_K + kws) = S.st_k0; *(bf16x8*)(lds + OFF_K + (bf) * SHM_K + kws + 32 * 256) = S.st_k1; \
                          if (MODE == 1) *(bf16x8*)(lds + OFF_KR + (bf) * SHM_KR + krws) = S.st_kr;                       \
                          if (MODE == 0) { if (tid < 64) ((float*)(lds + OFF_BIAS))[(bf) * 64 + tid] = S.st_b; } } while (0)
#define SWRITE_V(bf) do { *(bf16x8*)(lds + OFF_V + (bf) * SHM_V + vst0) = S.st_v0; *(bf16x8*)(lds + OFF_V + (bf) * SHM_V + vst1) = S.st_v1; } while (0)
#define SWRITE_KV(bf) do { SWRITE_V(bf); SWRITE_K(bf); } while (0)
#define QLOAD(R) do { _Pragma("unroll") for (int d0 = 0; d0 < 8; ++d0) S.qr[d0] = ld8((R).Q + (size_t)(wid * QBLK + r32) * Cfg<MODE>::QLD + d0 * 16 + hi * 8);   \
                      if (MODE == 1) { _Pragma("unroll") for (int d0 = 0; d0 < 4; ++d0) S.qr[(MODE ? 8 : 0) + d0] = ld8((R).Q + (size_t)(wid * QBLK + r32) * Cfg<MODE>::QLD + 128 + d0 * 16 + hi * 8); } } while (0)

template <int MODE>
__device__ __forceinline__ void attn_block_np(const BlockRef& cur, char* lds) {
    int tid_ = threadIdx.x; asm volatile("" : "+v"(tid_));
    const int tid = tid_, wid = __builtin_amdgcn_readfirstlane(tid >> 6), lane = tid & 63, r32 = lane & 31, hi = lane >> 5;
    const int NT = (cur.P0 + QB) / KVBLK;
    const int qlo = cur.P0 + wid * QBLK, qm = qlo + r32 - 4 * hi;
    float* ws = (float*)(lds + OFF_WS) + wid * 64; float* li_l = ws, * al_l = ws + 32;
    float m_reg = -1e30f, l_reg = 0; f32x16 o[4] = {};
    const int sr = tid >> 4, sc = (tid & 15) * 8, vst0 = v_st(sr, sc), vst1 = v_st(32 + sr, sc), kws = KSWZ(sr, sc * 2), krws = KSWZ((tid >> 3) & 31, ((tid >> 8) * 64 + (tid & 7) * 8) * 2);
    const int vb0 = (int)(uintptr_t)(lds + OFF_V) + v_rd_base(lane);
    Seam<MODE> S;
    QLOAD(cur);
    SLOAD(cur, 0); VMW(); SWRITE_KV(0);
    __syncthreads();
#define RESC(a) do { if (__any((a) < 1.f)) { if (hi == 0) al_l[r32] = (a); asm volatile("s_waitcnt lgkmcnt(0)" ::: "memory");              \
                     for (int d_ = 0; d_ < 4; ++d_) for (int r = 0; r < 16; ++r) o[d_][r] *= al_l[crow(r, hi)]; } } while (0)
#define KBASE(t) ((t) * KVBLK)
#define ACT(t) (MODE == 1 ? ((t) <= (qlo >> 6)) : (KBASE(t) <= qlo + QBLK - 1))
#define MASKT(P0_, P1_, t) do { if (MODE == 0) { const int kb_ = KBASE(t); if (kb_ + KVBLK - 1 > qlo) mask_tile(P0_, P1_, qm - kb_); } } while (0)
    f32x16 p0, p1; float mn, al; bf16x8 pa0, pa1, pa2, pa3;
#define STEP(t, KB) do {                                                                                                       \
        if ((t) + 1 < NT) { SLOAD(cur, KBASE((t) + 1)); }                                                                      \
        SBAR();                                                                                                                \
        if (ACT(t)) {                                                                                                          \
            qkt<KB, MODE>(p0, p1, lds, r32, hi, S.qr, true);                                                                   \
            MASKT(p0, p1, (t)); partialSM<MODE>(p0, p1, m_reg, mn, al); RESC(al);                                              \
            finishSM(p0, p1, al, l_reg, pa0, pa1, pa2, pa3); SBAR();                                                           \
            pv_tile<KB, false>(o, vb0, pa0, pa1, pa2, pa3, true);                                                              \
        }                                                                                                                      \
        SBAR();                                                                                                                \
        if ((t) + 1 < NT) { VMW(); SWRITE_KV((KB) ^ 1); }                                                                      \
        __syncthreads(); } while (0)
    for (int t = 0; t < NT; t += 2) { STEP(t, 0); STEP(t + 1, 1); }
    if (hi == 0) li_l[r32] = l_reg; asm volatile("s_waitcnt lgkmcnt(0)" ::: "memory");
    float rli[16];
#pragma unroll
    for (int r = 0; r < 16; ++r) rli[r] = __builtin_amdgcn_rcpf(li_l[crow(r, hi)]);
    bf16* Ow = cur.O + (size_t)(wid * QBLK) * LDO;
#pragma unroll
    for (int r = 0; r < 16; ++r) { const int orow = crow(r, hi);
#pragma unroll
        for (int d0 = 0; d0 < 4; ++d0) { const float v = o[d0][r] * rli[r];
            const float vn = __shfl_xor(v, 1);
            if ((r32 & 1) == 0) *(unsigned*)(Ow + (size_t)orow * LDO + d0 * 32 + r32) = cvtpk(v, vn); } }
    __syncthreads();
#undef RESC
#undef KBASE
#undef ACT
#undef MASKT
#undef STEP
}
#if ATT_PIPE_FOX || ATT_PIPE_MLA
template <int MODE>
__device__ __forceinline__ void attn_prime(const BlockRef& cur, char* lds, Seam<MODE>& S) {
    int tid_ = threadIdx.x; asm volatile("" : "+v"(tid_));
    const int tid = tid_, wid = __builtin_amdgcn_readfirstlane(tid >> 6), lane = tid & 63, r32 = lane & 31, hi = lane >> 5;
    const int sr = tid >> 4, sc = (tid & 15) * 8, kws = KSWZ(sr, sc * 2), krws = KSWZ((tid >> 3) & 31, ((tid >> 8) * 64 + (tid & 7) * 8) * 2);
    QLOAD(cur);
    SLOAD(cur, 0); VMW(); SWRITE_K(0);
    __syncthreads();
}
template <int MODE>
__device__ __forceinline__ void attn_block(const BlockRef& cur, const BlockRef& nxt, char* lds, Seam<MODE>& S) {
    constexpr bool SK = (MODE == 1);
    int tid_ = threadIdx.x; asm volatile("" : "+v"(tid_));
    const int tid = tid_, wid = __builtin_amdgcn_readfirstlane(tid >> 6), lane = tid & 63, r32 = lane & 31, hi = lane >> 5;
    const int NT = (cur.P0 + QB) / KVBLK;
    const int qlo = cur.P0 + wid * QBLK, qm = qlo + r32 - 4 * hi;
    float* ws = (float*)(lds + OFF_WS) + wid * 64; float* li_l = ws, * al_l = ws + 32;
    float m_reg = -1e30f, l_reg = 0; f32x16 o[4] = {};
    const int sr = tid >> 4, sc = (tid & 15) * 8, vst0 = v_st(sr, sc), vst1 = v_st(32 + sr, sc), kws = KSWZ(sr, sc * 2), krws = KSWZ((tid >> 3) & 31, ((tid >> 8) * 64 + (tid & 7) * 8) * 2);
    const int vb0 = (int)(uintptr_t)(lds + OFF_V) + v_rd_base(lane);
#define RESC(a) do { if (__any((a) < 1.f)) { if (hi == 0) al_l[r32] = (a); asm volatile("s_waitcnt lgkmcnt(0)" ::: "memory");              \
                     for (int d_ = 0; d_ < 4; ++d_) for (int r = 0; r < 16; ++r) o[d_][r] *= al_l[crow(r, hi)]; } } while (0)
#define KBASE(t) ((t) * KVBLK)
#define ACT(t) (!SK || ((t) <= (qlo >> 6)))
#define MASKT(P0_, P1_, t) do { if (MODE == 0) { const int kb_ = KBASE(t); if (kb_ + KVBLK - 1 > qlo) mask_tile(P0_, P1_, qm - kb_); } } while (0)
    constexpr int NQL = Cfg<MODE>::NQ;
#define SEAM_K0() do { VMWN(NQL); SWRITE_K(0); SBAR(); } while (0)
    f32x16 pA0, pA1, pB0, pB1; float mnA, mnB, alA, alB; bf16x8 pa0, pa1, pa2, pa3;
    SWRITE_V(0); SBAR();
    if (NT > 1) SLOAD(cur, KBASE(1));
    SBAR(); qkt<0, MODE>(pA0, pA1, lds, r32, hi, S.qr, ACT(0));
    MASKT(pA0, pA1, 0); partialSM<MODE>(pA0, pA1, m_reg, mnA, alA);
    if (NT > 1) { VMW(); SWRITE_KV(1); }
    __syncthreads();
#define HALF_STEP(PX0, PX1, mnX, alX, PY0, PY1, alY, t, KB, VB, SB) do {                                                      \
        SBAR(); qkt<KB, MODE>(PX0, PX1, lds, r32, hi, S.qr, ACT(t));                                             \
        finishSM(PY0, PY1, alY, l_reg, pa0, pa1, pa2, pa3); SBAR();                                                           \
        if ((t) + 1 < NT) { SLOAD(cur, KBASE((t) + 1)); SBAR(); }                                               \
        pv_tile<VB, SK>(o, vb0, pa0, pa1, pa2, pa3, ACT((t) - 1)); MASKT(PX0, PX1, (t)); partialSM<MODE>(PX0, PX1, m_reg, mnX, alX);      \
        __syncthreads();                                                                                                      \
        if ((t) + 1 < NT) { VMW(); SWRITE_KV(SB); }                                                                          \
        RESC(alX); __syncthreads(); } while (0)
    for (int t = 1; t + 1 < NT; t += 2) {
        HALF_STEP(pB0, pB1, mnB, alB, pA0, pA1, alA, t, 1, 0, 0);
        HALF_STEP(pA0, pA1, mnA, alA, pB0, pB1, alB, t + 1, 0, 1, 1);
    }
    const bool even = (NT & 1) == 0;
    if (even) { SBAR(); qkt<1, MODE>(pB0, pB1, lds, r32, hi, S.qr, ACT(NT - 1)); SBAR(); }
    SLOAD(nxt, 0); SBAR();
    QLOAD(nxt);
    SBAR();
    finishSM(pA0, pA1, alA, l_reg, pa0, pa1, pa2, pa3); SBAR();
    pv_tile<0, SK>(o, vb0, pa0, pa1, pa2, pa3, ACT(even ? NT - 2 : NT - 1));
    if (even) { MASKT(pB0, pB1, NT - 1); partialSM<MODE>(pB0, pB1, m_reg, mnB, alB); __syncthreads(); RESC(alB);
        finishSM(pB0, pB1, alB, l_reg, pa0, pa1, pa2, pa3); SBAR(); pv_tile<1, SK>(o, vb0, pa0, pa1, pa2, pa3, ACT(NT - 1)); }
    SBAR(); SEAM_K0();
    if (hi == 0) li_l[r32] = l_reg; asm volatile("s_waitcnt lgkmcnt(0)" ::: "memory");
    float rli[16];
#pragma unroll
    for (int r = 0; r < 16; ++r) rli[r] = __builtin_amdgcn_rcpf(li_l[crow(r, hi)]);
    bf16* Ow = cur.O + (size_t)(wid * QBLK) * LDO;
#pragma unroll
    for (int r = 0; r < 16; ++r) { const int orow = crow(r, hi);
#pragma unroll
        for (int d0 = 0; d0 < 4; ++d0) { const float v = o[d0][r] * rli[r];
            const float vn = __shfl_xor(v, 1);
            if ((r32 & 1) == 0) *(unsigned*)(Ow + (size_t)orow * LDO + d0 * 32 + r32) = cvtpk(v, vn); } }
    __syncthreads();
#undef RESC
#undef KBASE
#undef ACT
#undef MASKT
#undef SEAM_K0
#undef HALF_STEP
}
#endif
#undef ROWKV
#undef VMW
#undef VMWN
#undef SLOAD
#undef SWRITE_K
#undef SWRITE_V
#undef SWRITE_KV
#undef QLOAD
#undef KSWZ
#undef SBAR
}
#define GAS __attribute__((address_space(1)))
#define LAS __attribute__((address_space(3)))
typedef unsigned short bf16b;
typedef unsigned v4u __attribute__((ext_vector_type(4)));
typedef float f32x4 __attribute__((ext_vector_type(4)));
constexpr size_t MiB = 1u << 20;
constexpr size_t WS_SQ = 1008 * MiB, WS_SKV = 1009 * MiB, WS_SH1 = 1010 * MiB, WS_SH2 = 1014 * MiB;
constexpr size_t WS_ROPE = 1 * MiB;
constexpr size_t WS_WIN = 4 * MiB, WS_WUQ = 36 * MiB, WS_WUKV = 38 * MiB, WS_WM = 40 * MiB, WS_WF = 44 * MiB, WS_WOUT = 48 * MiB, WS_WUP = 56 * MiB, WS_WDOWN = 88 * MiB;
constexpr size_t WS_XN = 120 * MiB;
constexpr size_t WS_CQ = 248 * MiB, WS_CKV = 280 * MiB, WS_KR = 296 * MiB, WS_FF = 300 * MiB, WS_BIAS = 301 * MiB;
constexpr size_t WS_FQ = 304 * MiB;
constexpr size_t WS_GATES = 496 * MiB;
constexpr size_t WS_KN = 752 * MiB, WS_VM = 816 * MiB, WS_OM = 880 * MiB, WS_OF = 944 * MiB, WS_END = 1018 * MiB;
constexpr size_t WS_U = 432 * MiB;
constexpr int LDS_TOTAL = 131072 + 1024;
static_assert(att::LDS_BYTES <= 131072, "attention LDS");

#define XB_TMO      128
#define XB_XCNT(j)  (256  + 64 * (j))
#define XB_XSUB(j)  (1280 + 64 * (j))
#define XB_XGEN(j)  (2304 + 64 * (j))
#define XB_TOP      3328
#define XB_TOPGEN   3392
#define XCD_BAR_WORDS 3456
#define XB_SPIN_CAP (1u << 18)

__device__ __forceinline__ unsigned xb_ld(unsigned* p)              { return __hip_atomic_load(p, __ATOMIC_RELAXED, __HIP_MEMORY_SCOPE_AGENT); }
__device__ __forceinline__ unsigned xb_add(unsigned* p, unsigned v) { return __hip_atomic_fetch_add(p, v, __ATOMIC_RELAXED, __HIP_MEMORY_SCOPE_AGENT); }
__device__ __forceinline__ unsigned xb_xcc_id() { return (unsigned)__builtin_amdgcn_s_getreg((3 << 11) | 20) & 0xFu; }
#define XB_SPIN(cond, bar) do { unsigned _sp = 0; while (cond) { __builtin_amdgcn_s_sleep(1); \
    if ((++_sp & 255u) == 0u) { if (xb_ld(&(bar)[XB_TMO])) break; if (_sp > XB_SPIN_CAP) { atomicAdd(&(bar)[XB_TMO], 1u); break; } } } } while (0)

struct XcdBarrier {
    unsigned* bar; unsigned x;
    volatile LAS unsigned* st;
};

__device__ __forceinline__ XcdBarrier xcd_barrier_post(unsigned* bar, volatile LAS unsigned* st) {
    XcdBarrier b; b.bar = bar; b.x = xb_xcc_id(); b.st = st;
    if (threadIdx.x == 0) (void)xb_add(&bar[XB_XCNT(b.x)], 1u);
    return b;
}
__device__ __forceinline__ void xcd_barrier_complete(unsigned* bar, unsigned x, unsigned& nloc, unsigned& nx) {
    const unsigned G = gridDim.x * gridDim.y * gridDim.z;
    unsigned sum, cnt, mine, sp = 0u;
    for (;;) {
        sum = 0u; cnt = 0u; mine = 0u;
#pragma unroll
        for (unsigned j = 0; j < 16; ++j) { const unsigned c = xb_ld(&bar[XB_XCNT(j)]); sum += c; cnt += (c > 0u) ? 1u : 0u; mine = (j == x) ? c : mine; }
        if (sum == G) break;
        __builtin_amdgcn_s_sleep(1);
        if ((++sp & 255u) == 0u) { if (xb_ld(&bar[XB_TMO])) break; if (sp > XB_SPIN_CAP) { atomicAdd(&bar[XB_TMO], 1u); break; } }
    }
    nloc = mine > 0u ? mine : 1u; nx = cnt > 0u ? cnt : 1u;
}

__device__ __forceinline__ void xcd_barrier(const XcdBarrier& b) {
    asm volatile("s_waitcnt vmcnt(0)" ::: "memory");
    __syncthreads();
    if (threadIdx.x == 0) {
        unsigned* bar = b.bar;
        __builtin_amdgcn_s_waitcnt(0);
        unsigned nloc = b.st[0], nx = b.st[1];
        if (nloc == 0u) { xcd_barrier_complete(bar, b.x, nloc, nx); b.st[0] = nloc; b.st[1] = nx; }
        const unsigned old = xb_add(&bar[XB_XSUB(b.x)], 1u);
        const unsigned gen = old / nloc;
        if (old + 1u == (gen + 1u) * nloc) {
            __builtin_amdgcn_fence(__ATOMIC_RELEASE, "agent");
            asm volatile("s_waitcnt vmcnt(0)" ::: "memory");
            const unsigned og = xb_add(&bar[XB_TOP], 1u);
            const unsigned tg = og / nx;
            if (og + 1u == (tg + 1u) * nx) xb_add(&bar[XB_TOPGEN], 1u);
            else XB_SPIN(xb_ld(&bar[XB_TOPGEN]) == tg, bar);
            __builtin_amdgcn_fence(__ATOMIC_ACQUIRE, "agent");
            xb_add(&bar[XB_XGEN(b.x)], 1u);
            asm volatile("s_waitcnt vmcnt(0)" ::: "memory");
        } else {
            XB_SPIN(xb_ld(&bar[XB_XGEN(b.x)]) == gen, bar);
            __builtin_amdgcn_fence(__ATOMIC_ACQUIRE, "agent");
            asm volatile("s_waitcnt vmcnt(0)" ::: "memory");
        }
    }
    __syncthreads();
}

constexpr size_t WS_PCNT = 3 * MiB + 512 * 1024;
constexpr size_t WS_BAR = 3 * MiB;

struct Own { int xi, nx, lr, nloc; };
#ifndef BATCH_MAP
#define BATCH_MAP 1
#endif
__device__ __forceinline__ int own_panel(const Own& o, int k) {
    if (BATCH_MAP && o.nx == 8 && MROWS / 256 == 128) { if (k >= 16) return 1 << 20; const int s = o.xi & 1, qb = s ? 8 + k : (k < 8 ? k : 16 + k); return 32 * (o.xi >> 1) + qb; }
    return k * o.nx + ((k & 1) ? o.nx - 1 - o.xi : o.xi); }
__device__ __forceinline__ int own_npan(const Own& o, int nM) { int n = 0; while (own_panel(o, n) < nM) ++n; return n; }
#ifndef XGM
#define XGM 4
#endif
struct XOrder {
    Own o; int nN, npan, nunits;
    __device__ __forceinline__ void init(int M, int N, const Own& o_) { o = o_; if (!OWN_GEMM) { o.nx = 8; o.nloc = gridDim.x / 8; o.xi = blockIdx.x % 8; o.lr = blockIdx.x / 8; } nN = N / 256; npan = own_npan(o, M / 256); nunits = npan * nN; }
    __device__ __forceinline__ bool next(int i, pg8::Unit& u) const {
        const int L = i * o.nloc + o.lr; if (L >= nunits) return false;
        const int nig = XGM * nN, gid = L / nig, fm = gid * XGM, gsz = (npan - fm) < XGM ? (npan - fm) : XGM, r = L - gid * nig;
        u.pm = own_panel(o, fm + r % gsz); u.pn = r / gsz; return true;
    }
    __device__ __forceinline__ void a_ready(const pg8::Unit&) const {}
    __device__ __forceinline__ void done(const pg8::Unit&) const {}
};
#ifndef CUT_MASK
#define CUT_MASK (MK_MULTI ? 0xff : 0)
#endif
struct Args { const float* in[15]; float* out; unsigned char* ws; int ph_lo, ph_hi, li, pad; };

__device__ __forceinline__ unsigned f2bf(float f) { unsigned u = __builtin_bit_cast(unsigned, f); return (u + 0x7fffu + ((u >> 16) & 1u)) >> 16; }
__device__ __forceinline__ unsigned pk2(float lo, float hi) { return f2bf(lo) | (f2bf(hi) << 16); }
__device__ __forceinline__ float wave_sum(float v) {
#pragma unroll
    for (int o = 1; o < 64; o <<= 1) v += __shfl_xor(v, o);
    return v;
}
__device__ __forceinline__ int map_col(int id, int j) {
    if (id == 1) { if (j < 768) return j; if (j < 832) { const int i = j - 768; return 768 + (i < 32 ? 2 * i : 2 * (i - 32) + 1); }
                   if (j < 3904) return 1024 + (j - 832); if (j < 3912) return 832 + (j - 3904); return 4096 + (j - 3912); }
    if (id == 2) { const int h = j / 192, r = j - h * 192; if (r < 128) return j; const int i = r - 128; return 192 * h + 128 + (i < 32 ? 2 * i : 2 * (i - 32) + 1); }
    if (id == 3) { const int h = j >> 8, r = j & 255; return r < 128 ? 128 * h + r : 1024 + 128 * h + (r - 128); }
    return j;
}
__device__ __forceinline__ void p0_transpose_item(const float* W, int K, int N, bf16b* WT, const float* gain, int mapid, LAS float* scr, int item, int lane) {
    const int nblk = (N + 31) / 32, kb = item / nblk, nb = item - kb * nblk, k0 = 64 * kb, n0 = 32 * nb;
    const int col = n0 + (lane & 31);
#pragma unroll 8
    for (int i = 0; i < 32; ++i) { const int kk = 2 * i + (lane >> 5); float v = 0.f; if (col < N) { v = W[(size_t)(k0 + kk) * N + col]; if (gain) v *= gain[k0 + kk]; } scr[kk * 33 + (lane & 31)] = v; }
    asm volatile("s_waitcnt lgkmcnt(0)" ::: "memory");
    const int c = lane & 7;
#pragma unroll
    for (int j = 0; j < 4; ++j) { const int n = (lane >> 3) + 8 * j; const LAS float* s = scr + (8 * c) * 33 + n;
        if (n0 + n < N) { v4u o; o.x = pk2(s[0 * 33], s[1 * 33]); o.y = pk2(s[2 * 33], s[3 * 33]); o.z = pk2(s[4 * 33], s[5 * 33]); o.w = pk2(s[6 * 33], s[7 * 33]);
            *(v4u*)(WT + (size_t)map_col(mapid, n0 + n) * K + k0 + 8 * c) = o; } }
    asm volatile("s_waitcnt lgkmcnt(0)" ::: "memory");
}


struct TDesc { const float* W; const float* gain; bf16b* WT; int K, N, mapid, item; };
__device__ __forceinline__ void p0_item_load(const TDesc& d, int lane, f32x4 (&v)[8], float (&g)[8]) {
    const int nblk = (d.N + 31) / 32, kb = d.item / nblk, nb = d.item - kb * nblk, k0 = 64 * kb, col = 32 * nb + 4 * (lane & 7), kr = lane >> 3;
#pragma unroll
    for (int i = 0; i < 8; ++i) { const int k = k0 + 8 * i + kr; v[i] = (f32x4){0.f, 0.f, 0.f, 0.f}; if (col < d.N) v[i] = *(const f32x4*)(d.W + (size_t)k * d.N + col); g[i] = d.gain ? d.gain[k] : 1.f; }
}
__device__ __forceinline__ void p0_item_store(const TDesc& d, int lane, const f32x4 (&v)[8], const float (&g)[8], LAS float* scr) {
    const int nblk = (d.N + 31) / 32, kb = d.item / nblk, nb = d.item - kb * nblk, k0 = 64 * kb, n0 = 32 * nb, kr = lane >> 3, c4 = lane & 7;
#pragma unroll
    for (int i = 0; i < 8; ++i) { LAS float* s = scr + (8 * i + kr) * 33 + 4 * c4; const f32x4 xv = v[i] * g[i]; s[0] = xv.x; s[1] = xv.y; s[2] = xv.z; s[3] = xv.w; }
    asm volatile("s_waitcnt lgkmcnt(0)" ::: "memory");
    const int c = lane & 7;
#pragma unroll
    for (int j = 0; j < 4; ++j) { const int n = (lane >> 3) + 8 * j; const LAS float* s = scr + (8 * c) * 33 + n;
        if (n0 + n < d.N) { v4u o; o.x = pg8::cvt_pk_bf16(s[0 * 33], s[1 * 33]); o.y = pg8::cvt_pk_bf16(s[2 * 33], s[3 * 33]); o.z = pg8::cvt_pk_bf16(s[4 * 33], s[5 * 33]); o.w = pg8::cvt_pk_bf16(s[6 * 33], s[7 * 33]);
            *(v4u*)(d.WT + (size_t)map_col(d.mapid, n0 + n) * d.K + k0 + 8 * c) = o; } }
    asm volatile("s_waitcnt lgkmcnt(0)" ::: "memory");
}

__global__ void __launch_bounds__(512) fwd_megakernel(Args args) {
    extern __shared__ __attribute__((aligned(16))) unsigned char lds[];
    LAS unsigned char* ldsL = (LAS unsigned char*)lds;
    const int tid = threadIdx.x, lane = tid & 63, wave = __builtin_amdgcn_readfirstlane(tid >> 6);
    const int G = gridDim.x, bx = blockIdx.x;
    const int vcu = (G % 8 == 0) ? (bx % 8) * (G / 8) + bx / 8 : bx;
    unsigned char* ws = args.ws;
    const float* x = args.in[0];
    float* out = args.out;
    float* SQ = (float*)(ws + WS_SQ); float* SKV = (float*)(ws + WS_SKV); float* SH1 = (float*)(ws + WS_SH1); float* SH2 = (float*)(ws + WS_SH2); float* ROPE = (float*)(ws + WS_ROPE);
    bf16b* Win_t = (bf16b*)(ws + WS_WIN); bf16b* Wuq_t = (bf16b*)(ws + WS_WUQ); bf16b* Wukv_t = (bf16b*)(ws + WS_WUKV); bf16b* Wm_t = (bf16b*)(ws + WS_WM);
    bf16b* Wf_t = (bf16b*)(ws + WS_WF); bf16b* Wout_t = (bf16b*)(ws + WS_WOUT); bf16b* Wup_t = (bf16b*)(ws + WS_WUP); bf16b* Wdown_t = (bf16b*)(ws + WS_WDOWN);
    bf16b* XN = (bf16b*)(ws + WS_XN); bf16b* QM = XN; bf16b* MIX = XN;
    bf16b* CQ = (bf16b*)(ws + WS_CQ); bf16b* CKV = (bf16b*)(ws + WS_CKV); bf16b* KR = (bf16b*)(ws + WS_KR); float* FF = (float*)(ws + WS_FF); float* BIASK = (float*)(ws + WS_BIAS);
    bf16b* FQ = (bf16b*)(ws + WS_FQ); bf16b* H1B = FQ; bf16b* GATES = (bf16b*)(ws + WS_GATES);
    bf16b* KN = (bf16b*)(ws + WS_KN); bf16b* VM = (bf16b*)(ws + WS_VM); bf16b* OM = (bf16b*)(ws + WS_OM); bf16b* OF = (bf16b*)(ws + WS_OF); bf16b* U = (bf16b*)(ws + WS_U);
    const int lo = args.ph_lo, hi = args.ph_hi;
    volatile LAS unsigned* bst = (volatile LAS unsigned*)(ldsL + 131072);
    XcdBarrier bar; bar.bar = (unsigned*)(ws + WS_BAR) + args.li * XCD_BAR_WORDS; bar.x = xb_xcc_id(); bar.st = bst;
    if (tid == 0) {
        const unsigned lr_ = xb_add(&bar.bar[XB_XCNT(bar.x)], 1u);
        unsigned sum, cnt, mine, xi_, sp = 0u;
        for (;;) { sum = 0u; cnt = 0u; mine = 0u; xi_ = 0u;
#pragma unroll
            for (unsigned j = 0; j < 16; ++j) { const unsigned c = xb_ld(&bar.bar[XB_XCNT(j)]); sum += c; if (j == bar.x) { mine = c; xi_ = cnt; } cnt += (c > 0u) ? 1u : 0u; }
            if (sum == (unsigned)G) break;
            __builtin_amdgcn_s_sleep(1);
            if (++sp > (1u << 22)) break; }
        bst[0] = mine > 0u ? mine : 1u; bst[1] = cnt > 0u ? cnt : 1u; bst[4] = xi_; bst[5] = lr_;
    }
    __syncthreads();
    Own own; own.nloc = (int)bst[0]; own.nx = (int)bst[1]; own.xi = (int)bst[4]; own.lr = (int)bst[5];
    own.nloc = __builtin_amdgcn_readfirstlane(own.nloc); own.nx = __builtin_amdgcn_readfirstlane(own.nx); own.xi = __builtin_amdgcn_readfirstlane(own.xi); own.lr = __builtin_amdgcn_readfirstlane(own.lr);
    if (args.ph_lo < 0) cg::this_grid().sync();
#ifndef PHMASK
#define PHMASK 0x1ff
#endif
#define IN(k) (((PHMASK >> (k)) & 1) && lo <= (k) && (k) < hi)
#ifndef REPMASK
#define REPMASK 0
#endif
#define REP(k) (((REPMASK >> (k)) & 1) ? 2 : 1)
#define SEAM(k) do { if (IN(k) && IN((k) + 1)) xcd_barrier(bar); } while (0)
    pg8::Epi E{}; E.CQ = CQ; E.CKV = CKV; E.KR = KR; E.FQKV = FQ; E.GATES = GATES; E.QM = QM; E.KN = KN; E.VM = VM; E.MIX = MIX; E.TMP = FQ; E.H1B = H1B; E.U = U;
    E.GN = args.in[14]; E.PCNT = (unsigned*)(ws + WS_PCNT); E.fuse8 = (!MK_MULTI && CUT_MASK == 0 && XGM == 4 && own.nloc == 32) ? 1 : 0;
    E.FF = FF; E.SQ = SQ; E.SKV = SKV; E.SH1 = SH1; E.SH2 = SH2; E.OUT = out; E.X = x; E.ROPE = ROPE;

    if (IN(0)) for (int rp_ = 0; rp_ < REP(0); ++rp_) {
        const int gw = bx * 8 + wave, NGW = G * 8;
        LAS float* scr = (LAS float*)(ldsL + wave * 16384);
        constexpr int I_IN = 32 * 251, I_UQ = 8 * 48, I_UKV = 4 * 64, I_BR = 16 * 64, I_OUT = 32 * 64, I_UP = 32 * 256, I_DN = 128 * 64;
        constexpr int NITEMS = I_IN + I_UQ + I_UKV + 2 * I_BR + I_OUT + I_UP + I_DN;
#define P0_DECODE(D, it_) do { int r = (it_); \
            if (r < I_IN) { (D) = TDesc{args.in[2], args.in[1], Win_t, 2048, DIN, 1, r}; } else { r -= I_IN; \
            if (r < I_UQ) { (D) = TDesc{args.in[5], args.in[4], Wuq_t, 512, 1536, 2, r}; } else { r -= I_UQ; \
            if (r < I_UKV) { (D) = TDesc{args.in[7], args.in[6], Wukv_t, 256, 2048, 3, r}; } else { r -= I_UKV; \
            if (r < I_BR) { (D) = TDesc{args.in[8], nullptr, Wm_t, 1024, 2048, 0, r}; } else { r -= I_BR; \
            if (r < I_BR) { (D) = TDesc{args.in[9], nullptr, Wf_t, 1024, 2048, 0, r}; } else { r -= I_BR; \
            if (r < I_OUT) { (D) = TDesc{args.in[10], nullptr, Wout_t, 2048, 2048, 0, r}; } else { r -= I_OUT; \
            if (r < I_UP) { (D) = TDesc{args.in[12], args.in[11], Wup_t, 2048, 8192, 0, r}; } else { r -= I_UP; \
            (D) = TDesc{args.in[13], nullptr, Wdown_t, 8192, 2048, 0, r}; } } } } } } } } while (0)
        if (gw < NITEMS) {
            int it = gw; TDesc dc; P0_DECODE(dc, it); f32x4 vc[8]; float gc[8]; p0_item_load(dc, lane, vc, gc);
            for (;;) { const int itn = it + NGW; const bool has = itn < NITEMS; TDesc dn = dc; f32x4 vn[8]; float gn[8];
                if (has) { P0_DECODE(dn, itn); p0_item_load(dn, lane, vn, gn); }
                p0_item_store(dc, lane, vc, gc, scr);
                if (!has) break;
#pragma unroll
                for (int i = 0; i < 8; ++i) { vc[i] = vn[i]; gc[i] = gn[i]; }
                dc = dn; it = itn; }
        }
#undef P0_DECODE
        Own ownr = own; if (!OWN_ROWS) { ownr.nx = 8; ownr.nloc = G / 8; ownr.xi = bx % 8; ownr.lr = bx / 8; }
        const int npan0 = own_npan(ownr, MROWS / 256), xend = npan0 * 256, xstep = ownr.nloc * 8;
        { int idx = ownr.lr * 8 + wave;
          if (idx < xend) { f32x4 v[8]; int m = own_panel(ownr, idx >> 8) * 256 + (idx & 255);
#pragma unroll
            for (int j = 0; j < 8; ++j) v[j] = ((const f32x4*)(x + (size_t)m * DMODEL) + lane)[64 * j];
            for (;;) { const int idn = idx + xstep; const bool has = idn < xend; f32x4 w[8]; int mn = m;
                if (has) { mn = own_panel(ownr, idn >> 8) * 256 + (idn & 255);
#pragma unroll
                    for (int j = 0; j < 8; ++j) w[j] = ((const f32x4*)(x + (size_t)mn * DMODEL) + lane)[64 * j]; }
                float s = 0.f;
#pragma unroll
                for (int j = 0; j < 8; ++j) s += (v[j].x * v[j].x + v[j].y * v[j].y) + (v[j].z * v[j].z + v[j].w * v[j].w);
                const float rs = rsqrtf(wave_sum(s) * (1.f / DMODEL) + EPS);
                unsigned long long* o8 = (unsigned long long*)(XN + (size_t)m * DMODEL) + lane;
#pragma unroll
                for (int j = 0; j < 8; ++j) o8[64 * j] = (unsigned long long)pg8::cvt_pk_bf16(v[j].x * rs, v[j].y * rs) | ((unsigned long long)pg8::cvt_pk_bf16(v[j].z * rs, v[j].w * rs) << 32);
                if (!has) break;
#pragma unroll
                for (int j = 0; j < 8; ++j) v[j] = w[j];
                idx = idn; m = mn; } } }
        const int gt = bx * 512 + tid, NGT = G * 512;
        for (int i = gt; i < SEQ * 32; i += NGT) { const int pos = i >> 5, k = i & 31;
            const float inv = 1.0f / powf(10000.0f, (float)k * (1.0f / 32.0f)); const float ang = (float)pos * inv;
            const double rev = (double)ang * 0.15915494309189535; const float fr = (float)(rev - __builtin_rint(rev));
            ROPE[2 * i] = __builtin_amdgcn_cosf(fr); ROPE[2 * i + 1] = __builtin_amdgcn_sinf(fr); }
    }
    SEAM(0);
    if (IN(1)) for (int rp_ = 0; rp_ < REP(1); ++rp_) { pg8::Gemm g{XN, Win_t, MROWS, NPROJ, 2048}; XOrder S; S.init(MROWS, NPROJ, own); E.mode = EM_PROJ;
        pg8::gemm_phase<pg8::Epi, XOrder, true, true>(ldsL, g, S, E); }
    SEAM(1);
    if (IN(2)) for (int rp_ = 0; rp_ < REP(2); ++rp_) {
        if (bx < 32) {
            const int b = bx >> 3, h = bx & 7; const float fb = args.in[3][h]; float v[16]; float run = 0.f;
#pragma unroll
            for (int i = 0; i < 16; ++i) { const float z = FF[((size_t)b * SEQ + tid * 16 + i) * 8 + h] + fb; const float ls = fminf(z, 0.f) - log1pf(expf(-fabsf(z))); run += ls; v[i] = run; }
            float incl = run;
#pragma unroll
            for (int o = 1; o < 64; o <<= 1) { const float t = __shfl_up(incl, o); if (lane >= o) incl += t; }
            LAS float* wt = (LAS float*)ldsL;
            if (lane == 63) wt[wave] = incl;
            __syncthreads();
            float base = incl - run;
            for (int w = 0; w < wave; ++w) base += wt[w];
            float* dst = BIASK + ((size_t)bx * SEQ + tid * 16);
#pragma unroll
            for (int i = 0; i < 16; ++i) dst[i] = -(base + v[i]) * 11.313708498984761f;
            __syncthreads();
        }
        { pg8::Gemm g{CQ, Wuq_t, MROWS, 1536, 512}; XOrder S; S.init(MROWS, 1536, own); E.mode = EM_QUP;
          pg8::gemm_phase<pg8::Epi, XOrder, true, true>(ldsL, g, S, E); }
        { pg8::Gemm g{CKV, Wukv_t, MROWS, 2048, 256}; XOrder S; S.init(MROWS, 2048, own); E.mode = EM_KVUP;
          pg8::gemm_phase<pg8::Epi, XOrder, true, true>(ldsL, g, S, E); }
    }
    SEAM(2);
    if (IN(3)) {
        using att::bf16; using att::BlockRef;
        Own owna = own; if (!OWN_ATT) { owna.nx = 8; owna.nloc = G / 8; owna.xi = bx % 8; owna.lr = bx / 8; }
        const int npanA = own_npan(owna, MROWS / 256); const bool fastdeal = (owna.nx == 8 && owna.nloc == 32 && npanA == 16);
#define MKREF(R, MODE_, e_) do { int pm_, h_; if (fastdeal && BATCH_MAP) { const int i_ = (e_) >> 6, which_ = ((e_) >> 5) & 1, l_ = (e_) & 31, p_ = l_ & 7, s_ = owna.xi & 1; h_ = 4 * i_ + (l_ >> 3); \
                pm_ = 32 * (owna.xi >> 1) + (which_ == 0 ? (s_ ? 23 - p_ : 31 - p_) : (s_ ? 8 + p_ : p_)); }     \
            else if (fastdeal) { const int j_ = (e_) & 31, i_ = (e_) >> 5; pm_ = own_panel(owna, (j_ >> 3) * 4 + i_); h_ = j_ & 7; } else { pm_ = own_panel(owna, (e_) >> 3); h_ = (e_) & 7; } \
            const int b_ = pm_ >> 5, qb_ = pm_ & 31, grp_ = b_ * 8 + h_; const size_t rb_ = (size_t)b_ * SEQ, rq_ = rb_ + (size_t)qb_ * 256; (R).P0 = qb_ * 256; \
            if ((MODE_) == 0) { (R).Q = (const bf16*)FQ + rq_ * 1024 + h_ * 128; (R).K = (const bf16*)FQ + (size_t)MROWS * 1024 + rb_ * 1024 + h_ * 128; (R).V = (const bf16*)FQ + (size_t)MROWS * 2048 + rb_ * 1024 + h_ * 128; \
                (R).O = (bf16*)OF + rq_ * 1024 + h_ * 128; (R).KR = nullptr; (R).BIAS = BIASK + (size_t)grp_ * SEQ; } \
            else { (R).Q = (const bf16*)QM + rq_ * 1536 + h_ * 192; (R).K = (const bf16*)KN + rb_ * 1024 + h_ * 128; (R).V = (const bf16*)VM + rb_ * 1024 + h_ * 128; \
                (R).O = (bf16*)OM + rq_ * 1024 + h_ * 128; (R).KR = (const bf16*)KR + rb_ * 64; (R).BIAS = nullptr; } } while (0)
#define STREAM(MODE_) do { for (int e = owna.lr; e < npanA * 8; e += owna.nloc) { BlockRef cur; MKREF(cur, MODE_, e); att::attn_block_np<MODE_>(cur, (char*)lds); } } while (0)
#if ATT_PIPE_FOX || ATT_PIPE_MLA
#define STREAMP(MODE_) do { int e = owna.lr; if (e < npanA * 8) { BlockRef cur, nxt; MKREF(cur, MODE_, e); att::Seam<MODE_> S; att::attn_prime<MODE_>(cur, (char*)lds, S); \
            for (;;) { const int en = e + owna.nloc; const bool last = en >= npanA * 8; if (last) nxt = cur; else MKREF(nxt, MODE_, en); \
                att::attn_block<MODE_>(cur, nxt, (char*)lds, S); if (last) break; cur = nxt; e = en; } } } while (0)
#endif
#ifndef ATT_REPEAT
#define ATT_REPEAT 1
#endif
        for (int rep = 0; rep < ATT_REPEAT; ++rep) {
#ifndef NO_FOX
#if ATT_PIPE_FOX
        STREAMP(0);
#else
        STREAM(0);
#endif
#endif
#ifndef NO_MLA
#if ATT_PIPE_MLA
        STREAMP(1);
#else
        STREAM(1);
#endif
#endif
        }
#undef STREAM
#undef MKREF
    }
    SEAM(3);
    if (IN(4)) for (int rp_ = 0; rp_ < REP(4); ++rp_) {
        { pg8::Gemm g{OM, Wm_t, MROWS, 2048, 1024}; XOrder S; S.init(MROWS, 2048, own); E.mode = EM_BR1;
          pg8::gemm_phase<pg8::Epi, XOrder, true, true>(ldsL, g, S, E); }
        { pg8::Gemm g{OF, Wf_t, MROWS, 2048, 1024}; XOrder S; S.init(MROWS, 2048, own); E.mode = EM_BR2;
          pg8::gemm_phase<pg8::Epi, XOrder, true, true>(ldsL, g, S, E); }
    }
    SEAM(4);
    if (IN(5)) for (int rp_ = 0; rp_ < REP(5); ++rp_) { pg8::Gemm g{MIX, Wout_t, MROWS, 2048, 2048}; XOrder S; S.init(MROWS, 2048, own); E.mode = EM_OUT;
        pg8::gemm_phase<pg8::Epi, XOrder, true, true>(ldsL, g, S, E); }
    SEAM(5);
    if (IN(6)) for (int rp_ = 0; rp_ < REP(6); ++rp_) { pg8::Gemm g{H1B, Wup_t, MROWS, DFF, 2048}; XOrder S; S.init(MROWS, DFF, own); E.mode = EM_UP;
        pg8::gemm_phase<pg8::Epi, XOrder, true, true>(ldsL, g, S, E); }
    SEAM(6);
    if (IN(7)) { pg8::Gemm g{U, Wdown_t, MROWS, 2048, DFF}; XOrder S; S.init(MROWS, 2048, own); E.mode = EM_DOWN;
        pg8::gemm_phase<pg8::Epi, XOrder, true, true>(ldsL, g, S, E); }
    SEAM(7);
    if (IN(8) && !E.fuse8) {
        const float* gn = args.in[14]; Own ownr = own; if (!OWN_ROWS) { ownr.nx = 8; ownr.nloc = G / 8; ownr.xi = bx % 8; ownr.lr = bx / 8; } const int npan8 = own_npan(ownr, MROWS / 256);
        f32x4 gv[8];
#pragma unroll
        for (int j = 0; j < 8; ++j) gv[j] = ((const f32x4*)gn)[lane + 64 * j];
        for (int idx = ownr.lr * 8 + wave; idx < npan8 * 256; idx += ownr.nloc * 8) { const int m = own_panel(ownr, idx >> 8) * 256 + (idx & 255); f32x4* orow = (f32x4*)(out + (size_t)m * DMODEL) + lane; const int r_ = m & 255; float sq = lane < 32 ? SH2[((((size_t)(m >> 8) * 32 + lane) * 2 + ((r_ >> 6) & 1)) * 16 + (r_ & 15)) * 8 + (r_ >> 7) * 4 + ((r_ >> 4) & 3)] : 0.f; sq = wave_sum(sq); const float rs = rsqrtf(sq * (1.f / DMODEL) + EPS);
#pragma unroll
            for (int j = 0; j < 8; ++j) { f32x4 v = orow[64 * j]; orow[64 * j] = v * rs * gv[j]; } }
    }
#undef IN
#undef SEAM
}

extern "C" void kernel_launch(void* const* d_in, const int* in_sizes, int n_in, void* d_out, int out_size, void* d_ws, size_t ws_size, hipStream_t stream) {
    static int grid = 0;
    if (grid == 0) {
        if (n_in != 15 || in_sizes[0] != MROWS * DMODEL || out_size != MROWS * DMODEL || ws_size < WS_END) {
            fprintf(stderr, "kernel_launch: unexpected shapes (n_in %d, in0 %d, out %d, ws %zu < %zu)\n", n_in, n_in > 0 ? in_sizes[0] : -1, out_size, ws_size, (size_t)WS_END); grid = -1; return; }
        int dev = 0, cus = 0, per_cu = 0;
        (void)hipGetDevice(&dev); (void)hipDeviceGetAttribute(&cus, hipDeviceAttributeMultiprocessorCount, dev);
        if (hipFuncSetAttribute((const void*)fwd_megakernel, hipFuncAttributeMaxDynamicSharedMemorySize, LDS_TOTAL) != hipSuccess) { fprintf(stderr, "kernel_launch: hipFuncSetAttribute failed\n"); grid = -1; return; }
        if (hipOccupancyMaxActiveBlocksPerMultiprocessor(&per_cu, (const void*)fwd_megakernel, 512, LDS_TOTAL) != hipSuccess || per_cu < 1) { fprintf(stderr, "kernel_launch: occupancy query says %d\n", per_cu); per_cu = 1; }
        (void)hipGetLastError();
        if (cus <= 0) cus = 256;
        grid = cus;
    }
    if (grid < 0) return;
    Args a{};
    for (int i = 0; i < 15; ++i) a.in[i] = (const float*)d_in[i];
    a.out = (float*)d_out; a.ws = (unsigned char*)d_ws;
    (void)hipMemsetAsync((unsigned char*)d_ws + WS_BAR, 0, 512 * 1024 + 128 * 256, stream);
    int li = 0;
    for (int p = 0; p < 9; ) { int q = p; while (q < 8 && !((CUT_MASK >> q) & 1)) ++q;
        a.ph_lo = p; a.ph_hi = q + 1; a.li = li++;
        void* kargs[] = {&a};
        hipError_t e = hipLaunchCooperativeKernel((const void*)fwd_megakernel, dim3(grid), dim3(512), kargs, LDS_TOTAL, stream);
        if (e != hipSuccess) fprintf(stderr, "kernel_launch: cooperative launch failed: %s (grid %d)\n", hipGetErrorString(e), grid);
        p = q + 1; }
}
```

```cpp
#include <hip/hip_runtime.h>
#include <hip/hip_bf16.h>
#include <hip/hip_cooperative_groups.h>
#include <cstdio>
#include <cstdint>
namespace cg = cooperative_groups;

#ifndef MK_MULTI
#define MK_MULTI 0
#endif

#ifndef OWN_GEMM
#define OWN_GEMM 1
#endif
#ifndef OWN_ATT
#define OWN_ATT 1
#endif
#ifndef OWN_ROWS
#define OWN_ROWS 1
#endif
constexpr int BATCH = 4, SEQ = 8192, DMODEL = 2048, MROWS = BATCH * SEQ, DIN = 8008, NPROJ = 8192, DFF = 8192;
constexpr float EPS = 1e-6f;
enum { EM_PROJ = 0, EM_QUP, EM_KVUP, EM_BR1, EM_BR2, EM_OUT, EM_UP, EM_DOWN };
namespace pg8 {
#define PG8_LAS __attribute__((address_space(3)))
typedef unsigned short bf16_t;
typedef short bf16x8 __attribute__((ext_vector_type(8)));
typedef float f32x4 __attribute__((ext_vector_type(4)));
typedef unsigned u32x4 __attribute__((ext_vector_type(4)));
constexpr int BM = 256, BK = 64, HALF = 128, HTB = HALF * BK * 2  , STAGE_BYTES = 8 * HTB, NXCD = 8, WGM = 8;

__host__ __device__ __forceinline__ int lds_byte(int r, int c) { const int st = (r >> 4) * 2 + (c >> 5), rr = r & 15, cc = c & 31, ob = rr * 64 + cc * 2; return st * 1024 + (ob ^ (((ob >> 9) & 1) << 5)); }
__host__ __device__ __forceinline__ void stage_rc(int b, int& R, int& C) { const int st = b / 1024, sb = b % 1024, swz = sb ^ (((sb >> 9) & 1) << 5); R = (st >> 1) * 16 + swz / 64; C = (st & 1) * 32 + (swz % 64) / 2; }
__host__ __device__ __forceinline__ int perm32(int rho) { const int n = rho >> 4, i = rho & 15; return 8 * (i >> 2) + 4 * n + (i & 3); }

struct Unit { int pm, pn; };
struct Gemm { const bf16_t* A; const bf16_t* Bt; int M, N, K; };

struct StaticOrder {
    int nM, nN, nwg, G, c;
    __host__ __device__ void init(int M, int N, int G_, int c_) { nM = M / BM; nN = N / BM; nwg = nM * nN; G = G_; c = c_; }
    __host__ __device__ bool next(int i, Unit& u) const {
        const long L = (long)i * G + c; if (L >= nwg) return false;
        int wgid = (int)L; { const int q = nwg / NXCD, r = nwg % NXCD, xcd = wgid % NXCD, off = wgid / NXCD; wgid = (xcd < r ? xcd * (q + 1) : r * (q + 1) + (xcd - r) * q) + off; }
        const int nig = WGM * nN, gid = wgid / nig, fm = gid * WGM, gsz = (nM - fm) < WGM ? (nM - fm) : WGM;
        u.pm = fm + ((wgid % nig) % gsz); u.pn = (wgid % nig) / gsz; return true;
    }
    __device__ __forceinline__ void a_ready(const Unit&) const {}
    __device__ __forceinline__ void done(const Unit&) const {}
};

typedef float f32x2c_t __attribute__((ext_vector_type(2))); typedef __bf16 bf16x2c_t __attribute__((ext_vector_type(2)));
__device__ __forceinline__ unsigned cvt_pk_bf16(float lo, float hi) { f32x2c_t v = {lo, hi}; bf16x2c_t b = __builtin_convertvector(v, bf16x2c_t); return __builtin_bit_cast(unsigned, b); }
typedef float f32x2 __attribute__((ext_vector_type(2)));
typedef unsigned u32x2 __attribute__((ext_vector_type(2)));
__device__ __forceinline__ u32x4 pack8(f32x4 a, f32x4 b) { u32x4 w; w.x = cvt_pk_bf16(a[0], a[1]); w.y = cvt_pk_bf16(a[2], a[3]); w.z = cvt_pk_bf16(b[0], b[1]); w.w = cvt_pk_bf16(b[2], b[3]); return w; }
__device__ __forceinline__ void unpack8(u32x4 w, f32x4& a, f32x4& b) {
    a[0] = __uint_as_float(w.x << 16); a[1] = __uint_as_float(w.x & 0xffff0000u); a[2] = __uint_as_float(w.y << 16); a[3] = __uint_as_float(w.y & 0xffff0000u);
    b[0] = __uint_as_float(w.z << 16); b[1] = __uint_as_float(w.z & 0xffff0000u); b[2] = __uint_as_float(w.w << 16); b[3] = __uint_as_float(w.w & 0xffff0000u); }
__device__ __forceinline__ void rope8(f32x4& a, f32x4& b, const float* tab) {
    const f32x4 t0 = *(const f32x4*)tab, t1 = *(const f32x4*)(tab + 4);
    float x1, x2;
    x1 = a[0]; x2 = a[1]; a[0] = x1 * t0[0] - x2 * t0[1]; a[1] = x1 * t0[1] + x2 * t0[0];
    x1 = a[2]; x2 = a[3]; a[2] = x1 * t0[2] - x2 * t0[3]; a[3] = x1 * t0[3] + x2 * t0[2];
    x1 = b[0]; x2 = b[1]; b[0] = x1 * t1[0] - x2 * t1[1]; b[1] = x1 * t1[1] + x2 * t1[0];
    x1 = b[2]; x2 = b[3]; b[2] = x1 * t1[2] - x2 * t1[3]; b[3] = x1 * t1[3] + x2 * t1[2];
}
__device__ __forceinline__ void rope8v(f32x4& a, f32x4& b, const f32x4 t0, const f32x4 t1) {
    float x1, x2;
    x1 = a[0]; x2 = a[1]; a[0] = x1 * t0[0] - x2 * t0[1]; a[1] = x1 * t0[1] + x2 * t0[0];
    x1 = a[2]; x2 = a[3]; a[2] = x1 * t0[2] - x2 * t0[3]; a[3] = x1 * t0[3] + x2 * t0[2];
    x1 = b[0]; x2 = b[1]; b[0] = x1 * t1[0] - x2 * t1[1]; b[1] = x1 * t1[1] + x2 * t1[0];
    x1 = b[2]; x2 = b[3]; b[2] = x1 * t1[2] - x2 * t1[3]; b[3] = x1 * t1[3] + x2 * t1[2];
}
__device__ __forceinline__ float sigm(float v) { return __builtin_amdgcn_rcpf(1.f + __expf(-v)); }
__device__ __forceinline__ float sumsq8(f32x4 a, f32x4 b) { return (a[0] * a[0] + a[1] * a[1]) + (a[2] * a[2] + a[3] * a[3]) + (b[0] * b[0] + b[1] * b[1]) + (b[2] * b[2] + b[3] * b[3]); }
__device__ __forceinline__ void ssq_commit(float* p, float s, int fq) { s += __shfl_xor(s, 16); s += __shfl_xor(s, 32); if (fq == 0) *p = s; }
template <int NS> __device__ __forceinline__ float ssq_sum(const float* p) { float s = 0.f;
#pragma unroll
    for (int i = 0; i < NS / 4; ++i) { const f32x4 v = *(const f32x4*)(p + 4 * i); s += (v[0] + v[1]) + (v[2] + v[3]); } return s; }

template <int NS> __device__ __forceinline__ float ssq_sum_sh(const float* p, int fq) {
    float s;
    if (NS == 32) { const f32x4 a = *(const f32x4*)(p + 8 * fq), b = *(const f32x4*)(p + 8 * fq + 4); s = ((a[0] + a[1]) + (a[2] + a[3])) + ((b[0] + b[1]) + (b[2] + b[3])); }
    else if (NS == 8) { s = p[2 * fq] + p[2 * fq + 1]; }
    else { s = p[fq]; }
    s += __shfl_xor(s, 16); s += __shfl_xor(s, 32); return s;
}
__device__ __forceinline__ size_t sh_base(int pm, int s, int wr, int fr) { return ((((size_t)pm * 32 + s) * 2 + wr) * 16 + fr) * 8; }
__device__ __forceinline__ void sh_commit8(float* SH, int pm, int s, int wr, int fr, int fq, float (&ss)[8]) {
#pragma unroll
    for (int k = 0; k < 8; ++k) { ss[k] += __shfl_xor(ss[k], 16); ss[k] += __shfl_xor(ss[k], 32); }
    if (fq == 0) { float* p = SH + sh_base(pm, s, wr, fr); *(f32x4*)p = (f32x4){ss[0], ss[1], ss[2], ss[3]}; *(f32x4*)(p + 4) = (f32x4){ss[4], ss[5], ss[6], ss[7]}; }
}
template <bool FENCED> __device__ __forceinline__ void sh_sum8(const float* SH, int pm, int wr, int fr, int fq, float (&o8)[8]) {
    f32x4 a = {0.f, 0.f, 0.f, 0.f}, b = {0.f, 0.f, 0.f, 0.f};
#pragma unroll
    for (int j = 0; j < 8; ++j) { const float* p = SH + sh_base(pm, 8 * fq + j, wr, fr); a += *(const f32x4*)p; b += *(const f32x4*)(p + 4);
        if (FENCED && (j & 1) == 1) asm volatile("" : "+v"(a), "+v"(b) :: "memory"); }
#pragma unroll
    for (int k = 0; k < 4; ++k) { o8[k] = a[k]; o8[4 + k] = b[k]; }
#pragma unroll
    for (int k = 0; k < 8; ++k) { o8[k] += __shfl_xor(o8[k], 16); o8[k] += __shfl_xor(o8[k], 32); }
}
struct Epi {
    static constexpr bool PERM = true, AFTER_DRAIN = false;
    int mode;
    bf16_t *CQ, *CKV, *KR, *FQKV, *GATES, *QM, *KN, *VM, *MIX, *TMP, *H1B, *U;
    float *FF, *SQ, *SKV, *SH1, *SH2, *OUT; const float* X; const float* ROPE; const float* GN; unsigned* PCNT; int fuse8;
    __device__ __forceinline__ void operator()(f32x4 (&acc)[2][2][4][2], const Unit& u, int wr, int wc, int fr, int fq) const {
        const int rowb = u.pm * BM + wr * 64 + fr, colb = u.pn * BM + wc * 32 + 8 * fq;
        constexpr size_t MR = (size_t)MROWS; (void)MR;
#define ROWOF(ai, m) ((size_t)(rowb + (ai) * HALF + (m) * 16))
        if (mode == EM_PROJ) {
            const int pn = u.pn;
#pragma unroll
            for (int ai = 0; ai < 2; ++ai)
#pragma unroll
                for (int m = 0; m < 4; ++m) { const size_t rw = ROWOF(ai, m); const int row = (int)rw;
                    if (pn < 3) { float ss = 0.f;
#pragma unroll
                        for (int bj = 0; bj < 2; ++bj) { const int col = colb + bj * HALF; const f32x4 v0 = acc[ai][bj][m][0], v1 = acc[ai][bj][m][1]; ss += sumsq8(v0, v1);
                            if (pn < 2) *(u32x4*)(CQ + rw * 512 + col) = pack8(v0, v1); else *(u32x4*)(CKV + rw * 256 + (col - 512)) = pack8(v0, v1); }
                        if (pn < 2) ssq_commit(SQ + rw * 8 + pn * 4 + wc, ss, fq); else ssq_commit(SKV + rw * 4 + wc, ss, fq);
                    } else if (pn == 3) {
                        const int lc = wc * 32 + 8 * fq;
                        if (lc < 64) { if (m == 0) {
                                f32x4 tb[4][2];
#pragma unroll
                                for (int mm = 0; mm < 4; ++mm) { const float* tp = ROPE + ((ROWOF(ai, mm) & (size_t)(SEQ - 1)) * 32 + (size_t)(lc >> 1)) * 2; tb[mm][0] = *(const f32x4*)tp; tb[mm][1] = *(const f32x4*)(tp + 4); }
#pragma unroll
                                for (int mm = 0; mm < 4; ++mm) { f32x4 v0 = acc[ai][0][mm][0], v1 = acc[ai][0][mm][1]; rope8v(v0, v1, tb[mm][0], tb[mm][1]); *(u32x4*)(KR + ROWOF(ai, mm) * 64 + lc) = pack8(v0, v1); } } }
                        else if (lc == 64) { *(f32x4*)(FF + rw * 8) = acc[ai][0][m][0]; *(f32x4*)(FF + rw * 8 + 4) = acc[ai][0][m][1]; }
                    } else if (pn < 16) {
                        const int t = (pn - 4) >> 2;
#pragma unroll
                        for (int bj = 0; bj < 2; ++bj) { const int col = colb + bj * HALF - 1024 - t * 1024; *(u32x4*)(FQKV + (size_t)t * MR * 1024 + rw * 1024 + col) = pack8(acc[ai][bj][m][0], acc[ai][bj][m][1]); }
                    } else {
#pragma unroll
                        for (int bj = 0; bj < 2; ++bj) { const int col = colb + bj * HALF - 4096; f32x4 v0 = acc[ai][bj][m][0], v1 = acc[ai][bj][m][1];
#pragma unroll
                            for (int i = 0; i < 4; ++i) { v0[i] = sigm(v0[i]); v1[i] = sigm(v1[i]); }
                            *(u32x4*)(GATES + rw * 4096 + col) = pack8(v0, v1); }
                    }
                }
        } else if (mode == EM_QUP || mode == EM_KVUP || mode == EM_UP) {
            float rsv[2][4];
            if (mode == EM_UP) { float t8[8]; sh_sum8<false>(SH1, u.pm, wr, fr, fq, t8);
#pragma unroll
                for (int k = 0; k < 8; ++k) rsv[k >> 2][k & 3] = t8[k] * (1.f / 2048.f); }
            else {
#pragma unroll
                for (int ai = 0; ai < 2; ++ai)
#pragma unroll
                    for (int m = 0; m < 4; ++m) { const size_t rw = ROWOF(ai, m);
                        rsv[ai][m] = mode == EM_QUP ? ssq_sum_sh<8>(SQ + rw * 8, fq) * (1.f / 512.f) : ssq_sum_sh<4>(SKV + rw * 4, fq) * (1.f / 256.f); } }
#pragma unroll
            for (int ai = 0; ai < 2; ++ai)
#pragma unroll
                for (int m = 0; m < 4; ++m) rsv[ai][m] = rsqrtf(rsv[ai][m] + EPS);
            if (mode == EM_QUP) {
                const int g0 = (u.pn * 8 + wc) % 6, g1 = (u.pn * 8 + 4 + wc) % 6;
#pragma unroll
                for (int am = 0; am < 4; ++am) { const int ai = am >> 1, mb = (am & 1) * 2;
                    f32x4 tb[4][2][2];
#pragma unroll
                    for (int m = mb; m < mb + 2; ++m)
#pragma unroll
                        for (int bj = 0; bj < 2; ++bj) { const int g = bj ? g1 : g0;
                            if (g >= 4) { const float* tp = ROPE + ((ROWOF(ai, m) & (size_t)(SEQ - 1)) * 32 + (size_t)(((g - 4) * 32 + 8 * fq) >> 1)) * 2; tb[m][bj][0] = *(const f32x4*)tp; tb[m][bj][1] = *(const f32x4*)(tp + 4); } }
#pragma unroll
                    for (int m = mb; m < mb + 2; ++m) { const size_t rw = ROWOF(ai, m); const float rs = rsv[ai][m];
#pragma unroll
                        for (int bj = 0; bj < 2; ++bj) { const int col = colb + bj * HALF, g = bj ? g1 : g0; f32x4 v0 = acc[ai][bj][m][0] * rs, v1 = acc[ai][bj][m][1] * rs;
                            if (g >= 4) rope8v(v0, v1, tb[m][bj][0], tb[m][bj][1]);
                            *(u32x4*)(QM + rw * 1536 + col) = pack8(v0, v1); } }
                }
            } else if (mode == EM_KVUP) {
#pragma unroll
                for (int ai = 0; ai < 2; ++ai)
#pragma unroll
                    for (int m = 0; m < 4; ++m) { const size_t rw = ROWOF(ai, m); const float rs = rsv[ai][m];
#pragma unroll
                        for (int bj = 0; bj < 2; ++bj) { const int col = colb + bj * HALF; const f32x4 v0 = acc[ai][bj][m][0] * rs, v1 = acc[ai][bj][m][1] * rs;
                            if (u.pn < 4) *(u32x4*)(KN + rw * 1024 + col) = pack8(v0, v1); else *(u32x4*)(VM + rw * 1024 + (col - 1024)) = pack8(v0, v1); } }
            } else {
#pragma unroll
                for (int ai = 0; ai < 2; ++ai)
#pragma unroll
                    for (int m = 0; m < 4; ++m) { const size_t rw = ROWOF(ai, m); const float rs = rsv[ai][m];
#pragma unroll
                        for (int bj = 0; bj < 2; ++bj) { const int col = colb + bj * HALF; f32x4 v0 = acc[ai][bj][m][0], v1 = acc[ai][bj][m][1];
#pragma unroll
                            for (int i = 0; i < 4; ++i) { float a = fmaxf(v0[i], 0.f) * rs, b = fmaxf(v1[i], 0.f) * rs; v0[i] = a * a; v1[i] = b * b; }
                            *(u32x4*)(U + rw * 8192 + col) = pack8(v0, v1); } }
            }
        } else if (mode == EM_BR1) {
            u32x4 gt[2][4][2];
#pragma unroll
            for (int ai = 0; ai < 2; ++ai)
#pragma unroll
                for (int m = 0; m < 4; ++m)
#pragma unroll
                    for (int bj = 0; bj < 2; ++bj) gt[ai][m][bj] = *(const u32x4*)(GATES + ROWOF(ai, m) * 4096 + colb + bj * HALF);
#pragma unroll
            for (int ai = 0; ai < 2; ++ai)
#pragma unroll
                for (int m = 0; m < 4; ++m)
#pragma unroll
                    for (int bj = 0; bj < 2; ++bj) { f32x4 g0, g1; unpack8(gt[ai][m][bj], g0, g1);
                        *(u32x4*)(TMP + ROWOF(ai, m) * 2048 + colb + bj * HALF) = pack8(acc[ai][bj][m][0] * g0, acc[ai][bj][m][1] * g1); }
        } else if (mode == EM_BR2) {
#pragma unroll
            for (int ai = 0; ai < 2; ++ai) {
                u32x4 gt[4][2], tt[4][2];
#pragma unroll
                for (int m = 0; m < 4; ++m)
#pragma unroll
                    for (int bj = 0; bj < 2; ++bj) { gt[m][bj] = *(const u32x4*)(GATES + ROWOF(ai, m) * 4096 + 2048 + colb + bj * HALF); tt[m][bj] = *(const u32x4*)(TMP + ROWOF(ai, m) * 2048 + colb + bj * HALF); }
#pragma unroll
                for (int m = 0; m < 4; ++m)
#pragma unroll
                    for (int bj = 0; bj < 2; ++bj) { f32x4 g0, g1, t0, t1; unpack8(gt[m][bj], g0, g1); unpack8(tt[m][bj], t0, t1);
                        *(u32x4*)(MIX + ROWOF(ai, m) * 2048 + colb + bj * HALF) = pack8(t0 + acc[ai][bj][m][0] * g0, t1 + acc[ai][bj][m][1] * g1); }
            }
        } else if (mode == EM_DOWN && !fuse8) {
#pragma unroll
            for (int ai = 0; ai < 2; ++ai)
#pragma unroll
                for (int m = 0; m < 4; ++m) { const size_t rw = ROWOF(ai, m); float ss = 0.f;
#pragma unroll
                    for (int bj = 0; bj < 2; ++bj) { const size_t o = rw * 2048 + colb + bj * HALF; f32x4 r0, r1; unpack8(*(const u32x4*)(H1B + o), r0, r1); const f32x4 h0 = r0 + acc[ai][bj][m][0], h1 = r1 + acc[ai][bj][m][1];
                        *(f32x4*)(OUT + o) = h0; *(f32x4*)(OUT + o + 4) = h1; ss += sumsq8(h0, h1); }
                    ss += __shfl_xor(ss, 16); ss += __shfl_xor(ss, 32); if (fq == 0) SH2[sh_base(u.pm, u.pn * 4 + wc, wr, fr) + ai * 4 + m] = ss; }
        } else if (mode == EM_OUT) { float ss8[8];
            const float* RES = X;
#pragma unroll
            for (int ai = 0; ai < 2; ++ai) {
                f32x4 xin[4][2][2];
#pragma unroll
                for (int m = 0; m < 4; ++m)
#pragma unroll
                    for (int bj = 0; bj < 2; ++bj) { const size_t o = ROWOF(ai, m) * 2048 + colb + bj * HALF; xin[m][bj][0] = *(const f32x4*)(RES + o); xin[m][bj][1] = *(const f32x4*)(RES + o + 4); }
#pragma unroll
                for (int m = 0; m < 4; ++m) { const size_t rw = ROWOF(ai, m); float ss = 0.f;
#pragma unroll
                    for (int bj = 0; bj < 2; ++bj) { const size_t o = rw * 2048 + colb + bj * HALF; const f32x4 h0 = xin[m][bj][0] + acc[ai][bj][m][0], h1 = xin[m][bj][1] + acc[ai][bj][m][1];
                        *(u32x4*)(H1B + o) = pack8(h0, h1); ss += sumsq8(h0, h1); }
                    ss8[ai * 4 + m] = ss; }
            }
            sh_commit8(SH1, u.pm, u.pn * 4 + wc, wr, fr, fq, ss8);
        } else { float ss8[8];
#pragma unroll
            for (int ai = 0; ai < 2; ++ai) {
                u32x4 xin[4][2];
#pragma unroll
                for (int m = 0; m < 4; ++m)
#pragma unroll
                    for (int bj = 0; bj < 2; ++bj) xin[m][bj] = *(const u32x4*)(H1B + ROWOF(ai, m) * 2048 + colb + bj * HALF);
#pragma unroll
                for (int m = 0; m < 4; ++m) { float ss = 0.f;
#pragma unroll
                    for (int bj = 0; bj < 2; ++bj) { f32x4 r0, r1; unpack8(xin[m][bj], r0, r1); acc[ai][bj][m][0] += r0; acc[ai][bj][m][1] += r1; ss += sumsq8(acc[ai][bj][m][0], acc[ai][bj][m][1]); }
                    ss8[ai * 4 + m] = ss; }
                asm volatile("" ::: "memory"); }
            sh_commit8(SH2, u.pm, u.pn * 4 + wc, wr, fr, fq, ss8);
            asm volatile("s_waitcnt vmcnt(0)" ::: "memory");
            unsigned* c = PCNT + 64 * u.pm;
            if (fr == 0 && fq == 0) __hip_atomic_fetch_add(c, 1u, __ATOMIC_RELAXED, __HIP_MEMORY_SCOPE_AGENT);
            { unsigned sp = 0u; while (__hip_atomic_load(c, __ATOMIC_RELAXED, __HIP_MEMORY_SCOPE_AGENT) < 64u) { __builtin_amdgcn_s_sleep(1); if (++sp > (1u << 24)) break; } }
            __builtin_amdgcn_fence(__ATOMIC_ACQUIRE, "agent"); asm volatile("s_waitcnt vmcnt(0)" ::: "memory");
            float t8[8]; sh_sum8<false>(SH2, u.pm, wr, fr, fq, t8);
            f32x4 gv[2][2];
#pragma unroll
            for (int bj = 0; bj < 2; ++bj) { gv[bj][0] = *(const f32x4*)(GN + colb + bj * HALF); gv[bj][1] = *(const f32x4*)(GN + colb + bj * HALF + 4); }
#pragma unroll
            for (int ai = 0; ai < 2; ++ai)
#pragma unroll
                for (int m = 0; m < 4; ++m) { const size_t rw = ROWOF(ai, m); const float rs = rsqrtf(t8[ai * 4 + m] * (1.f / 2048.f) + EPS);
#pragma unroll
                    for (int bj = 0; bj < 2; ++bj) { const size_t o = rw * 2048 + colb + bj * HALF;
                        *(f32x4*)(OUT + o) = acc[ai][bj][m][0] * rs * gv[bj][0]; *(f32x4*)(OUT + o + 4) = acc[ai][bj][m][1] * rs * gv[bj][1]; } }
        }
#undef ROWOF
    }
};
template <class Epi, class Sched, bool ALIGN_EPI = false, bool SP2 = false>
__device__ __forceinline__ void gemm_phase(PG8_LAS unsigned char* lds, const Gemm g, const Sched& S, const Epi& E) {
    int tid_ = threadIdx.x; asm volatile("" : "+v"(tid_));
    const int tid = tid_, wid = __builtin_amdgcn_readfirstlane(tid >> 6), lane = tid & 63, wr = wid >> 2, wc = wid & 3, fr = lane & 15, fq = lane >> 4;
    const int K = g.K, nt = K / BK;
    unsigned voffA[2], voffB[2];
#pragma unroll
    for (int i = 0; i < 2; ++i) { int R, C; stage_rc(tid * 16 + i * 8192, R, C); const int Rb = Epi::PERM ? ((R & ~31) + perm32(R & 31)) : R;
        voffA[i] = (unsigned)(R * K + C) * 2u; voffB[i] = (unsigned)(Rb * K + C) * 2u; }
    const size_t kstep = (size_t)(BK * 2);
    const size_t hstep = (size_t)HALF * K * 2;
    const size_t tstep = 2 * hstep;
    const unsigned ldsw = (unsigned)wid * 1024u;
    const int aoff = lds_byte(wr * 64 + fr, fq * 8), boff = lds_byte(wc * 32 + fr, fq * 8);
#define PG8_SA(b, h) (((b) * 2 + (h)) * HTB)
#define PG8_SB(b, h) ((4 + (b) * 2 + (h)) * HTB)
#define PG8_STAGE(bufoff, gbase, voff) do { _Pragma("unroll") for (int _i = 0; _i < 2; ++_i) \
        __builtin_amdgcn_global_load_lds((const unsigned*)((const char*)(gbase) + (voff)[_i]), (PG8_LAS unsigned*)(lds + (bufoff) + ldsw + _i * 8192), 16, 0, 0); } while (0)
#define PG8_LDA(dst, b, h) do { _Pragma("unroll") for (int m = 0; m < 4; ++m) _Pragma("unroll") for (int k = 0; k < 2; ++k) dst[m][k] = *(const PG8_LAS bf16x8*)(lds + PG8_SA(b, h) + aoff + m * 2048 + k * 1024); } while (0)
#define PG8_LDB(dst, b, h) do { _Pragma("unroll") for (int n = 0; n < 2; ++n) _Pragma("unroll") for (int k = 0; k < 2; ++k) dst[n][k] = *(const PG8_LAS bf16x8*)(lds + PG8_SB(b, h) + boff + n * 2048 + k * 1024); } while (0)
#define PG8_MMA(ai, bj, At, Bt) do { __builtin_amdgcn_s_setprio(1); _Pragma("unroll") for (int m = 0; m < 4; ++m) _Pragma("unroll") for (int n = 0; n < 2; ++n) _Pragma("unroll") for (int k = 0; k < 2; ++k) \
        acc[ai][bj][m][n] = __builtin_amdgcn_mfma_f32_16x16x32_bf16(Bt[n][k], At[m][k], acc[ai][bj][m][n], 0, 0, 0); __builtin_amdgcn_s_setprio(0); } while (0)
#define PG8_WAIT_V(n) asm volatile("s_waitcnt vmcnt(" #n ")" ::: "memory")
#define PG8_WAIT_L(n) asm volatile("s_waitcnt lgkmcnt(" #n ")" ::: "memory")
#define PG8_BAR __builtin_amdgcn_s_barrier()
#define PG8_SCHED __builtin_amdgcn_sched_barrier(0)
    Unit cur, nxt; int ui = 0;
    if (!S.next(0, cur)) return;
    f32x4 acc[2][2][4][2];
#pragma unroll
    for (int a = 0; a < 2; ++a)
#pragma unroll
        for (int b = 0; b < 2; ++b)
#pragma unroll
            for (int m = 0; m < 4; ++m)
#pragma unroll
                for (int n = 0; n < 2; ++n) acc[a][b][m][n] = (f32x4){0.f, 0.f, 0.f, 0.f};
    bf16x8 At[4][2], B0[2][2], B1[2][2];
    const char* cA = (const char*)g.A + (size_t)cur.pm * tstep; const char* cB = (const char*)g.Bt + (size_t)cur.pn * tstep;
    S.a_ready(cur);
    if constexpr (SP2) {
        PG8_STAGE(PG8_SB(0, 0), cB, voffB); PG8_STAGE(PG8_SB(0, 1), cB + hstep, voffB); PG8_STAGE(PG8_SA(0, 0), cA, voffA); PG8_STAGE(PG8_SA(0, 1), cA + hstep, voffA);
        if (wr == 1) PG8_BAR;
        PG8_WAIT_V(2); PG8_BAR;
        PG8_STAGE(PG8_SB(1, 0), cB + kstep, voffB); PG8_STAGE(PG8_SA(1, 0), cA + kstep, voffA); PG8_STAGE(PG8_SB(1, 1), cB + hstep + kstep, voffB);
        PG8_WAIT_V(6); PG8_BAR;
    } else {
        PG8_STAGE(PG8_SB(0, 0), cB, voffB); PG8_STAGE(PG8_SA(0, 0), cA, voffA); PG8_STAGE(PG8_SB(0, 1), cB + hstep, voffB); PG8_STAGE(PG8_SA(0, 1), cA + hstep, voffA);
        if (wr == 1) PG8_BAR;
        PG8_WAIT_V(4); PG8_BAR;
        PG8_STAGE(PG8_SB(1, 0), cB + kstep, voffB); PG8_STAGE(PG8_SA(1, 0), cA + kstep, voffA); PG8_STAGE(PG8_SB(1, 1), cB + hstep + kstep, voffB);
        PG8_WAIT_V(6); PG8_BAR;
    }
    for (;;) {
        const bool has_next = S.next(ui + 1, nxt);
        const char* nA = has_next ? (const char*)g.A + (size_t)nxt.pm * tstep : cA; const char* nB = has_next ? (const char*)g.Bt + (size_t)nxt.pn * tstep : cB;
        for (int t = 0; t < nt; t += 2) {
            const bool last = (t == nt - 2);
            const char* a1 = cA + (size_t)(t + 1) * kstep;
            const char* a2 = last ? nA : cA + (size_t)(t + 2) * kstep; const char* b2 = last ? nB : cB + (size_t)(t + 2) * kstep;
            const char* a3 = a2 + kstep; const char* b3 = b2 + kstep;
            if (last && has_next) S.a_ready(nxt);
            if constexpr (SP2) {
            PG8_LDB(B0, 0, 0); PG8_LDB(B1, 0, 1); PG8_SCHED; PG8_LDA(At, 0, 0); PG8_STAGE(PG8_SA(1, 1), a1 + hstep, voffA);
            PG8_WAIT_V(8); PG8_WAIT_L(0); PG8_BAR; PG8_MMA(0, 0, At, B0); PG8_MMA(0, 1, At, B1); PG8_BAR; PG8_SCHED;
            PG8_LDA(At, 0, 1); PG8_STAGE(PG8_SB(0, 0), b2, voffB); PG8_STAGE(PG8_SB(0, 1), b2 + hstep, voffB); PG8_STAGE(PG8_SA(0, 0), a2, voffA);
            PG8_WAIT_V(8); PG8_WAIT_L(0); PG8_BAR; PG8_MMA(1, 0, At, B0); PG8_MMA(1, 1, At, B1); PG8_BAR; PG8_SCHED;
            PG8_LDB(B0, 1, 0); PG8_LDB(B1, 1, 1); PG8_SCHED; PG8_LDA(At, 1, 0); PG8_STAGE(PG8_SA(0, 1), a2 + hstep, voffA);
            PG8_WAIT_V(8); PG8_WAIT_L(0); PG8_BAR; PG8_MMA(0, 0, At, B0); PG8_MMA(0, 1, At, B1); PG8_BAR; PG8_SCHED;
            PG8_LDA(At, 1, 1); PG8_STAGE(PG8_SB(1, 0), b3, voffB); PG8_STAGE(PG8_SB(1, 1), b3 + hstep, voffB); PG8_STAGE(PG8_SA(1, 0), a3, voffA);
            PG8_WAIT_V(8); PG8_WAIT_L(0); PG8_BAR; PG8_MMA(1, 0, At, B0); PG8_MMA(1, 1, At, B1); PG8_BAR; PG8_SCHED;
            } else {
            PG8_LDB(B0, 0, 0); PG8_SCHED; PG8_LDA(At, 0, 0); PG8_STAGE(PG8_SA(1, 1), a1 + hstep, voffA);
            PG8_WAIT_L(8); PG8_BAR; PG8_WAIT_L(0); PG8_MMA(0, 0, At, B0); PG8_BAR; PG8_SCHED;
            PG8_LDB(B1, 0, 1); PG8_STAGE(PG8_SB(0, 0), b2, voffB);
            PG8_BAR; PG8_WAIT_L(0); PG8_MMA(0, 1, At, B1); PG8_BAR;
            PG8_LDA(At, 0, 1); PG8_STAGE(PG8_SA(0, 0), a2, voffA);
            PG8_BAR; PG8_WAIT_L(0); PG8_MMA(1, 0, At, B0); PG8_BAR; PG8_SCHED;
            PG8_STAGE(PG8_SB(0, 1), b2 + hstep, voffB);
            PG8_WAIT_V(6); PG8_BAR; PG8_MMA(1, 1, At, B1); PG8_BAR;
            PG8_LDB(B0, 1, 0); PG8_SCHED; PG8_LDA(At, 1, 0); PG8_STAGE(PG8_SA(0, 1), a2 + hstep, voffA);
            PG8_WAIT_L(8); PG8_BAR; PG8_WAIT_L(0); PG8_MMA(0, 0, At, B0); PG8_BAR; PG8_SCHED;
            PG8_LDB(B1, 1, 1); PG8_STAGE(PG8_SB(1, 0), b3, voffB);
            PG8_BAR; PG8_WAIT_L(0); PG8_MMA(0, 1, At, B1); PG8_BAR;
            PG8_LDA(At, 1, 1); PG8_STAGE(PG8_SA(1, 0), a3, voffA);
            PG8_BAR; PG8_WAIT_L(0); PG8_MMA(1, 0, At, B0); PG8_BAR; PG8_SCHED;
            PG8_STAGE(PG8_SB(1, 1), b3 + hstep, voffB);
            PG8_WAIT_V(6); PG8_BAR; PG8_MMA(1, 1, At, B1); PG8_BAR;
            }
        }
        if constexpr (ALIGN_EPI) { if (wr == 0) PG8_BAR; }
        if constexpr (!Epi::AFTER_DRAIN) { E(acc, cur, wr, wc, fr, fq); S.done(cur); }
        if (!has_next) break;
#pragma unroll
        for (int a = 0; a < 2; ++a)
#pragma unroll
            for (int b = 0; b < 2; ++b)
#pragma unroll
                for (int m = 0; m < 4; ++m)
#pragma unroll
                    for (int n = 0; n < 2; ++n) acc[a][b][m][n] = (f32x4){0.f, 0.f, 0.f, 0.f};
        cur = nxt; cA = nA; cB = nB; ++ui;
        if constexpr (ALIGN_EPI) { if (wr == 1) PG8_BAR; }
    }
    PG8_WAIT_V(0);
    if constexpr (!ALIGN_EPI) { if (wr == 0) PG8_BAR; }
    PG8_BAR;
    if constexpr (Epi::AFTER_DRAIN) { E.fused(acc, cur, wr, wc, fr, fq, lds, wid, lane); S.done(cur); }
#undef PG8_SA
#undef PG8_SB
#undef PG8_STAGE
#undef PG8_LDA
#undef PG8_LDB
#undef PG8_MMA
#undef PG8_WAIT_V
#undef PG8_WAIT_L
#undef PG8_BAR
#undef PG8_SCHED
}
}
#ifndef ATT_PIPE_FOX
#define ATT_PIPE_FOX 0
#endif
#ifndef ATT_PIPE_MLA
#define ATT_PIPE_MLA 0
#endif
namespace att {
using bf16 = __hip_bfloat16;
typedef short bf16x8 __attribute__((ext_vector_type(8)));
typedef short s16x4 __attribute__((ext_vector_type(4)));
typedef float f32x16 __attribute__((ext_vector_type(16)));
typedef float f32x4 __attribute__((ext_vector_type(4)));
typedef unsigned u32x4 __attribute__((ext_vector_type(4)));
constexpr int D = 128, NW = 8, QBLK = 32, KVBLK = 64, QB = NW * QBLK, LDKV = 1024, LDO = 1024;
constexpr int SHM_V = KVBLK * D * 2, SHM_K = KVBLK * D * 2, SHM_KR = KVBLK * 64 * 2;
constexpr int OFF_V = 0, OFF_K = 2 * SHM_V, OFF_KR = OFF_K + 2 * SHM_K, OFF_WS = OFF_KR + 2 * SHM_KR, OFF_BIAS = OFF_WS + NW * 64 * 4, LDS_BYTES = OFF_BIAS + 2 * 64 * 4;
constexpr float THR = 8.f;
template <int MODE> struct Cfg { static constexpr float SCALE = MODE ? 0.07216878364870322f : 0.08838834764831845f; static constexpr int QLD = MODE ? 1536 : 1024, NQ = MODE ? 12 : 8; };

#define KSWZ(row, colB) ((row) * 256 + ((colB) ^ (((row) & 7) << 4)))
#define SBAR() __builtin_amdgcn_sched_barrier(0)
__device__ __forceinline__ int v_st(int k, int c) { const int kk = (k & ~0xC) | ((k & 4) << 1) | ((k & 8) >> 1); return ((kk >> 3) * 4 + (c >> 5)) * 512 + ((kk & 7) * 32 + (c & 31)) * 2; }
__device__ __forceinline__ int v_rd_base(int lane) { return ((lane & 3) << 3) | (((lane >> 2) & 3) << 6) | (((lane >> 4) & 1) << 5) | (((lane >> 5) & 1) << 8); }
constexpr int v_rd_off(int d0, int ks, int half) { return d0 * 512 + ks * 4096 + half * 2048; }
__device__ __forceinline__ int crow(int r, int hi) { return (r & 3) + 8 * (r >> 2) + 4 * hi; }
__device__ __forceinline__ unsigned cvtpk(float lo, float hi) { unsigned r; asm volatile("v_cvt_pk_bf16_f32 %0, %1, %2" : "=v"(r) : "v"(lo), "v"(hi)); return r; }
__device__ __forceinline__ bf16x8 ld8(const bf16* p) { return *reinterpret_cast<const bf16x8*>(p); }
__device__ __forceinline__ void mask_tile(f32x16& p0, f32x16& p1, int dq) {
    const float NEG = -__builtin_inff();
#pragma unroll
    for (int r = 0; r < 16; ++r) { const int c = (r & 3) + 8 * (r >> 2); if (dq - c < 0) p0[r] = NEG; if (dq - c - 32 < 0) p1[r] = NEG; }
}
template <int MODE>
__device__ __forceinline__ void partialSM(f32x16& p0, f32x16& p1, float& m_reg, float& mn, float& alpha) {
    constexpr float SCALE = Cfg<MODE>::SCALE;
    float pmax = p0[0]; for (int r = 1; r < 16; ++r) pmax = fmaxf(pmax, p0[r]); for (int r = 0; r < 16; ++r) pmax = fmaxf(pmax, p1[r]);
    { auto rr = __builtin_amdgcn_permlane32_swap(__float_as_uint(pmax), __float_as_uint(pmax), false, false);
      pmax = fmaxf(__uint_as_float(rr[0]), __uint_as_float(rr[1])); }
    constexpr float C2 = 1.4426950408889634f * SCALE;
    if (__builtin_expect(__all((pmax - m_reg) * SCALE <= THR), 1)) { mn = m_reg; alpha = 1.f; }
    else { mn = fmaxf(m_reg, pmax); alpha = __builtin_amdgcn_exp2f((m_reg - mn) * C2); m_reg = mn; }
    const float mnL = -mn * C2;
    for (int r = 0; r < 16; ++r) p0[r] = fmaf(p0[r], C2, mnL); for (int r = 0; r < 16; ++r) p1[r] = fmaf(p1[r], C2, mnL);
    for (int r = 0; r < 16; ++r) p0[r] = __builtin_amdgcn_exp2f(p0[r]);
}
__device__ __forceinline__ void finishSM(f32x16& p0, f32x16& p1, float alpha, float& l_reg, bf16x8& pa0, bf16x8& pa1, bf16x8& pa2, bf16x8& pa3) {
    for (int r = 0; r < 16; ++r) p1[r] = __builtin_amdgcn_exp2f(p1[r]);
    float ps = 0; for (int r = 0; r < 16; ++r) ps += p0[r]; for (int r = 0; r < 16; ++r) ps += p1[r];
    { auto rr = __builtin_amdgcn_permlane32_swap(__float_as_uint(ps), __float_as_uint(ps), false, false);
      ps = __uint_as_float(rr[0]) + __uint_as_float(rr[1]); }
    l_reg = l_reg * alpha + ps;
#define PK4(P, B_, OUT) do { unsigned a0 = cvtpk(P[B_+0], P[B_+1]), a1 = cvtpk(P[B_+2], P[B_+3]);                          \
        unsigned b0 = cvtpk(P[B_+4], P[B_+5]), b1 = cvtpk(P[B_+6], P[B_+7]);                                             \
        auto r0 = __builtin_amdgcn_permlane32_swap(a0, b0, false, false); auto r1 = __builtin_amdgcn_permlane32_swap(a1, b1, false, false); \
        u32x4 w = {r0[0], r1[0], r0[1], r1[1]}; OUT = *reinterpret_cast<bf16x8*>(&w); } while (0)
    PK4(p0, 0, pa0); PK4(p0, 8, pa1); PK4(p1, 0, pa2); PK4(p1, 8, pa3);
#undef PK4
}
template <int KB, int MODE>
__device__ __forceinline__ void qkt(f32x16& p0, f32x16& p1, const char* lds, int r32, int hi, const bf16x8* qr, bool act) {
    if (MODE == 1 && !act) { const float NEG = -__builtin_inff();
#pragma unroll
        for (int r = 0; r < 16; ++r) { p0[r] = NEG; p1[r] = NEG; } return; }
    if (MODE == 0) { const float* bp = (const float*)(lds + OFF_BIAS) + KB * 64 + 4 * hi;
#pragma unroll
        for (int g = 0; g < 4; ++g) { const f32x4 a = *(const f32x4*)(bp + 8 * g), b = *(const f32x4*)(bp + 32 + 8 * g);
#pragma unroll
            for (int i = 0; i < 4; ++i) { p0[4 * g + i] = a[i]; p1[4 * g + i] = b[i]; } }
    } else { p0 = f32x16{}; p1 = f32x16{}; }
    int ko[4];
#pragma unroll
    for (int dd = 0; dd < 4; ++dd) ko[dd] = KSWZ(r32, (dd * 16 + hi * 8) * 2);
#pragma unroll
    for (int d0 = 0; d0 < 8; ++d0) { const char* a = lds + OFF_K + KB * SHM_K + ko[d0 & 3] + (d0 >> 2) * 128;
        bf16x8 b0 = *reinterpret_cast<const bf16x8*>(a);
        bf16x8 b1 = *reinterpret_cast<const bf16x8*>(a + 32 * 256);
        p0 = __builtin_amdgcn_mfma_f32_32x32x16_bf16(b0, qr[d0], p0, 0, 0, 0);
        p1 = __builtin_amdgcn_mfma_f32_32x32x16_bf16(b1, qr[d0], p1, 0, 0, 0);
        if ((d0 & 3) == 3) SBAR(); }
    if (MODE == 1) {
#pragma unroll
        for (int d0 = 0; d0 < 4; ++d0) { const char* a = lds + OFF_KR + KB * SHM_KR + ko[d0];
            bf16x8 b0 = *reinterpret_cast<const bf16x8*>(a);
            bf16x8 b1 = *reinterpret_cast<const bf16x8*>(a + 128);
            p0 = __builtin_amdgcn_mfma_f32_32x32x16_bf16(b0, qr[8 + d0], p0, 0, 0, 0);
            p1 = __builtin_amdgcn_mfma_f32_32x32x16_bf16(b1, qr[8 + d0], p1, 0, 0, 0); }
    }
}
template <int VB, bool SK>
__device__ __forceinline__ void pv_tile(f32x16* o, int vb0, bf16x8 pa0, bf16x8 pa1, bf16x8 pa2, bf16x8 pa3, bool act) {
    if (SK && !act) return;
#define TRRD(dst, off) asm volatile("ds_read_b64_tr_b16 %0, %1 offset:%2" : "=&v"(dst) : "v"(vb0), "i"(off) : "memory")
#define PV_D0(d0) do { s16x4 l0, l1, l2, l3, h0, h1, h2, h3; constexpr int b_ = VB * SHM_V + v_rd_off(d0, 0, 0); \
        TRRD(l0, b_); TRRD(h0, b_ + 2048); TRRD(l1, b_ + 4096); TRRD(h1, b_ + 6144); TRRD(l2, b_ + 8192); TRRD(h2, b_ + 10240); TRRD(l3, b_ + 12288); TRRD(h3, b_ + 14336); \
          \
        asm volatile("s_waitcnt lgkmcnt(6)" ::: "memory"); SBAR();   \
        o[d0] = __builtin_amdgcn_mfma_f32_32x32x16_bf16(pa0, (bf16x8){l0[0], l0[1], l0[2], l0[3], h0[0], h0[1], h0[2], h0[3]}, o[d0], 0, 0, 0); SBAR();  \
        asm volatile("s_waitcnt lgkmcnt(4)" ::: "memory"); SBAR();   \
        o[d0] = __builtin_amdgcn_mfma_f32_32x32x16_bf16(pa1, (bf16x8){l1[0], l1[1], l1[2], l1[3], h1[0], h1[1], h1[2], h1[3]}, o[d0], 0, 0, 0); SBAR();  \
        asm volatile("s_waitcnt lgkmcnt(2)" ::: "memory"); SBAR();   \
        o[d0] = __builtin_amdgcn_mfma_f32_32x32x16_bf16(pa2, (bf16x8){l2[0], l2[1], l2[2], l2[3], h2[0], h2[1], h2[2], h2[3]}, o[d0], 0, 0, 0); SBAR();  \
        asm volatile("s_waitcnt lgkmcnt(0)" ::: "memory"); SBAR();   \
        o[d0] = __builtin_amdgcn_mfma_f32_32x32x16_bf16(pa3, (bf16x8){l3[0], l3[1], l3[2], l3[3], h3[0], h3[1], h3[2], h3[3]}, o[d0], 0, 0, 0); } while (0)
    PV_D0(0); PV_D0(1); PV_D0(2); PV_D0(3);
#undef PV_D0
#undef TRRD
}

struct BlockRef { const bf16* Q; const bf16* K; const bf16* V; bf16* O; const bf16* KR; const float* BIAS; int P0; };
template <int MODE> struct Seam { bf16x8 qr[Cfg<MODE>::NQ]; bf16x8 st_v0, st_v1, st_k0, st_k1, st_kr; float st_b; };

#define ROWKV(p, k0, rr) ((p) + (size_t)((k0) + (rr)) * LDKV + sc)
#define VMW() asm volatile("s_waitcnt vmcnt(0)" ::: "memory")
#define VMWN(n) asm volatile("s_waitcnt vmcnt(%0)" :: "i"(n) : "memory")
#define SLOAD(R, k0) do { S.st_v0 = ld8(ROWKV((R).V, k0, sr)); S.st_v1 = ld8(ROWKV((R).V, k0, 32 + sr));              \
                          S.st_k0 = ld8(ROWKV((R).K, k0, sr)); S.st_k1 = ld8(ROWKV((R).K, k0, 32 + sr));              \
                          if (MODE == 1) S.st_kr = ld8((R).KR + (size_t)((k0) + (tid >> 3)) * 64 + (tid & 7) * 8);       \
                          if (MODE == 0) { if (tid < 64) S.st_b = (R).BIAS[(k0) + tid]; } } while (0)
#define SWRITE_K(bf) do { *(bf16x8*)(lds + OFF_K + (bf) * SHM_K + kws) = S.st_k0; *(bf16x8*)(lds + OFF_K + (bf) * SHM_K + kws + 32 * 256) = S.st_k1; \
                          if (MODE == 1) *(bf16x8*)(lds + OFF_KR + (bf) * SHM_KR + krws) = S.st_kr;                       \
                          if (MODE == 0) { if (tid < 64) ((float*)(lds + OFF_BIAS))[(bf) * 64 + tid] = S.st_b; } } while (0)
#define SWRITE_V(bf) do { *(bf16x8*)(lds + OFF_V + (bf) * SHM_V + vst0) = S.st_v0; *(bf16x8*)(lds + OFF_V + (bf) * SHM_V + vst1) = S.st_v1; } while (0)
#define SWRITE_KV(bf) do { SWRITE_V(bf); SWRITE_K(bf); } while (0)
#define QLOAD(R) do { _Pragma("unroll") for (int d0 = 0; d0 < 8; ++d0) S.qr[d0] = ld8((R).Q + (size_t)(wid * QBLK + r32) * Cfg<MODE>::QLD + d0 * 16 + hi * 8);   \
                      if (MODE == 1) { _Pragma("unroll") for (int d0 = 0; d0 < 4; ++d0) S.qr[(MODE ? 8 : 0) + d0] = ld8((R).Q + (size_t)(wid * QBLK + r32) * Cfg<MODE>::QLD + 128 + d0 * 16 + hi * 8); } } while (0)

template <int MODE>
__device__ __forceinline__ void attn_block_np(const BlockRef& cur, char* lds) {
    int tid_ = threadIdx.x; asm volatile("" : "+v"(tid_));
    const int tid = tid_, wid = __builtin_amdgcn_readfirstlane(tid >> 6), lane = tid & 63, r32 = lane & 31, hi = lane >> 5;
    const int NT = (cur.P0 + QB) / KVBLK;
    const int qlo = cur.P0 + wid * QBLK, qm = qlo + r32 - 4 * hi;
    float* ws = (float*)(lds + OFF_WS) + wid * 64; float* li_l = ws, * al_l = ws + 32;
    float m_reg = -1e30f, l_reg = 0; f32x16 o[4] = {};
    const int sr = tid >> 4, sc = (tid & 15) * 8, vst0 = v_st(sr, sc), vst1 = v_st(32 + sr, sc), kws = KSWZ(sr, sc * 2), krws = KSWZ((tid >> 3) & 31, ((tid >> 8) * 64 + (tid & 7) * 8) * 2);
    const int vb0 = (int)(uintptr_t)(lds + OFF_V) + v_rd_base(lane);
    Seam<MODE> S;
    QLOAD(cur);
    SLOAD(cur, 0); VMW(); SWRITE_KV(0);
    __syncthreads();
#define RESC(a) do { if (__any((a) < 1.f)) { if (hi == 0) al_l[r32] = (a); asm volatile("s_waitcnt lgkmcnt(0)" ::: "memory");              \
                     for (int d_ = 0; d_ < 4; ++d_) for (int r = 0; r < 16; ++r) o[d_][r] *= al_l[crow(r, hi)]; } } while (0)
#define KBASE(t) ((t) * KVBLK)
#define ACT(t) (MODE == 1 ? ((t) <= (qlo >> 6)) : (KBASE(t) <= qlo + QBLK - 1))
#define MASKT(P0_, P1_, t) do { if (MODE == 0) { const int kb_ = KBASE(t); if (kb_ + KVBLK - 1 > qlo) mask_tile(P0_, P1_, qm - kb_); } } while (0)
    f32x16 p0, p1; float mn, al; bf16x8 pa0, pa1, pa2, pa3;
#define STEP(t, KB) do {                                                                                                       \
        if ((t) + 1 < NT) { SLOAD(cur, KBASE((t) + 1)); }                                                                      \
        SBAR();                                                                                                                \
        if (ACT(t)) {                                                                                                          \
            qkt<KB, MODE>(p0, p1, lds, r32, hi, S.qr, true);                                                                   \
            MASKT(p0, p1, (t)); partialSM<MODE>(p0, p1, m_reg, mn, al); RESC(al);                                              \
            finishSM(p0, p1, al, l_reg, pa0, pa1, pa2, pa3); SBAR();                                                           \
            pv_tile<KB, false>(o, vb0, pa0, pa1, pa2, pa3, true);                                                              \
        }                                                                                                                      \
        SBAR();                                                                                                                \
        if ((t) + 1 < NT) { VMW(); SWRITE_KV((KB) ^ 1); }                                                                      \
        __syncthreads(); } while (0)
    for (int t = 0; t < NT; t += 2) { STEP(t, 0); STEP(t + 1, 1); }
    if (hi == 0) li_l[r32] = l_reg; asm volatile("s_waitcnt lgkmcnt(0)" ::: "memory");
    float rli[16];
#pragma unroll
    for (int r = 0; r < 16; ++r) rli[r] = __builtin_amdgcn_rcpf(li_l[crow(r, hi)]);
    bf16* Ow = cur.O + (size_t)(wid * QBLK) * LDO;
#pragma unroll
    for (int r = 0; r < 16; ++r) { const int orow = crow(r, hi);
#pragma unroll
        for (int d0 = 0; d0 < 4; ++d0) { const float v = o[d0][r] * rli[r];
            const float vn = __shfl_xor(v, 1);
            if ((r32 & 1) == 0) *(unsigned*)(Ow + (size_t)orow * LDO + d0 * 32 + r32) = cvtpk(v, vn); } }
    __syncthreads();
#undef RESC
#undef KBASE
#undef ACT
#undef MASKT
#undef STEP
}
#if ATT_PIPE_FOX || ATT_PIPE_MLA
template <int MODE>
__device__ __forceinline__ void attn_prime(const BlockRef& cur, char* lds, Seam<MODE>& S) {
    int tid_ = threadIdx.x; asm volatile("" : "+v"(tid_));
    const int tid = tid_, wid = __builtin_amdgcn_readfirstlane(tid >> 6), lane = tid & 63, r32 = lane & 31, hi = lane >> 5;
    const int sr = tid >> 4, sc = (tid & 15) * 8, kws = KSWZ(sr, sc * 2), krws = KSWZ((tid >> 3) & 31, ((tid >> 8) * 64 + (tid & 7) * 8) * 2);
    QLOAD(cur);
    SLOAD(cur, 0); VMW(); SWRITE_K(0);
    __syncthreads();
}
template <int MODE>
__device__ __forceinline__ void attn_block(const BlockRef& cur, const BlockRef& nxt, char* lds, Seam<MODE>& S) {
    constexpr bool SK = (MODE == 1);
    int tid_ = threadIdx.x; asm volatile("" : "+v"(tid_));
    const int tid = tid_, wid = __builtin_amdgcn_readfirstlane(tid >> 6), lane = tid & 63, r32 = lane & 31, hi = lane >> 5;
    const int NT = (cur.P0 + QB) / KVBLK;
    const int qlo = cur.P0 + wid * QBLK, qm = qlo + r32 - 4 * hi;
    float* ws = (float*)(lds + OFF_WS) + wid * 64; float* li_l = ws, * al_l = ws + 32;
    float m_reg = -1e30f, l_reg = 0; f32x16 o[4] = {};
    const int sr = tid >> 4, sc = (tid & 15) * 8, vst0 = v_st(sr, sc), vst1 = v_st(32 + sr, sc), kws = KSWZ(sr, sc * 2), krws = KSWZ((tid >> 3) & 31, ((tid >> 8) * 64 + (tid & 7) * 8) * 2);
    const int vb0 = (int)(uintptr_t)(lds + OFF_V) + v_rd_base(lane);
#define RESC(a) do { if (__any((a) < 1.f)) { if (hi == 0) al_l[r32] = (a); asm volatile("s_waitcnt lgkmcnt(0)" ::: "memory");              \
                     for (int d_ = 0; d_ < 4; ++d_) for (int r = 0; r < 16; ++r) o[d_][r] *= al_l[crow(r, hi)]; } } while (0)
#define KBASE(t) ((t) * KVBLK)
#define ACT(t) (!SK || ((t) <= (qlo >> 6)))
#define MASKT(P0_, P1_, t) do { if (MODE == 0) { const int kb_ = KBASE(t); if (kb_ + KVBLK - 1 > qlo) mask_tile(P0_, P1_, qm - kb_); } } while (0)
    constexpr int NQL = Cfg<MODE>::NQ;
#define SEAM_K0() do { VMWN(NQL); SWRITE_K(0); SBAR(); } while (0)
    f32x16 pA0, pA1, pB0, pB1; float mnA, mnB, alA, alB; bf16x8 pa0, pa1, pa2, pa3;
    SWRITE_V(0); SBAR();
    if (NT > 1) SLOAD(cur, KBASE(1));
    SBAR(); qkt<0, MODE>(pA0, pA1, lds, r32, hi, S.qr, ACT(0));
    MASKT(pA0, pA1, 0); partialSM<MODE>(pA0, pA1, m_reg, mnA, alA);
    if (NT > 1) { VMW(); SWRITE_KV(1); }
    __syncthreads();
#define HALF_STEP(PX0, PX1, mnX, alX, PY0, PY1, alY, t, KB, VB, SB) do {                                                      \
        SBAR(); qkt<KB, MODE>(PX0, PX1, lds, r32, hi, S.qr, ACT(t));                                             \
        finishSM(PY0, PY1, alY, l_reg, pa0, pa1, pa2, pa3); SBAR();                                                           \
        if ((t) + 1 < NT) { SLOAD(cur, KBASE((t) + 1)); SBAR(); }                                               \
        pv_tile<VB, SK>(o, vb0, pa0, pa1, pa2, pa3, ACT((t) - 1)); MASKT(PX0, PX1, (t)); partialSM<MODE>(PX0, PX1, m_reg, mnX, alX);      \
        __syncthreads();                                                                                                      \
        if ((t) + 1 < NT) { VMW(); SWRITE_KV(SB); }                                                                          \
        RESC(alX); __syncthreads(); } while (0)
    for (int t = 1; t + 1 < NT; t += 2) {
        HALF_STEP(pB0, pB1, mnB, alB, pA0, pA1, alA, t, 1, 0, 0);
        HALF_STEP(pA0, pA1, mnA, alA, pB0, pB1, alB, t + 1, 0, 1, 1);
    }
    const bool even = (NT & 1) == 0;
    if (even) { SBAR(); qkt<1, MODE>(pB0, pB1, lds, r32, hi, S.qr, ACT(NT - 1)); SBAR(); }
    SLOAD(nxt, 0); SBAR();
    QLOAD(nxt);
    SBAR();
    finishSM(pA0, pA1, alA, l_reg, pa0, pa1, pa2, pa3); SBAR();
    pv_tile<0, SK>(o, vb0, pa0, pa1, pa2, pa3, ACT(even ? NT - 2 : NT - 1));
    if (even) { MASKT(pB0, pB1, NT - 1); partialSM<MODE>(pB0, pB1, m_reg, mnB, alB); __syncthreads(); RESC(alB);
        finishSM(pB0, pB1, alB, l_reg, pa0, pa1, pa2, pa3); SBAR(); pv_tile<1, SK>(o, vb0, pa0, pa1, pa2, pa3, ACT(NT - 1)); }
    SBAR(); SEAM_K0();
    if (hi == 0) li_l[r32] = l_reg; asm volatile("s_waitcnt lgkmcnt(0)" ::: "memory");
    float rli[16];
#pragma unroll
    for (int r = 0; r < 16; ++r) rli[r] = __builtin_amdgcn_rcpf(li_l[crow(r, hi)]);
    bf16* Ow = cur.O + (size_t)(wid * QBLK) * LDO;
#pragma unroll
    for (int r = 0; r < 16; ++r) { const int orow = crow(r, hi);
#pragma unroll
        for (int d0 = 0; d0 < 4; ++d0) { const float v = o[d0][r] * rli[r];
            const float vn = __shfl_xor(v, 1);
            if ((r32 & 1) == 0) *(unsigned*)(Ow + (size_t)orow * LDO + d0 * 32 + r32) = cvtpk(v, vn); } }
    __syncthreads();
#undef RESC
#undef KBASE
#undef ACT
#undef MASKT
#undef SEAM_K0
#undef HALF_STEP
}
#endif
#undef ROWKV
#undef VMW
#undef VMWN
#undef SLOAD
#undef SWRITE_K
#undef SWRITE_V
#undef SWRITE_KV
#undef QLOAD
#undef KSWZ
#undef SBAR
}
#define GAS __attribute__((address_space(1)))
#define LAS __attribute__((address_space(3)))
typedef unsigned short bf16b;
typedef unsigned v4u __attribute__((ext_vector_type(4)));
typedef float f32x4 __attribute__((ext_vector_type(4)));
constexpr size_t MiB = 1u << 20;
constexpr size_t WS_SQ = 1008 * MiB, WS_SKV = 1009 * MiB, WS_SH1 = 1010 * MiB, WS_SH2 = 1014 * MiB;
constexpr size_t WS_ROPE = 1 * MiB;
constexpr size_t WS_WIN = 4 * MiB, WS_WUQ = 36 * MiB, WS_WUKV = 38 * MiB, WS_WM = 40 * MiB, WS_WF = 44 * MiB, WS_WOUT = 48 * MiB, WS_WUP = 56 * MiB, WS_WDOWN = 88 * MiB;
constexpr size_t WS_XN = 120 * MiB;
constexpr size_t WS_CQ = 248 * MiB, WS_CKV = 280 * MiB, WS_KR = 296 * MiB, WS_FF = 300 * MiB, WS_BIAS = 301 * MiB;
constexpr size_t WS_FQ = 304 * MiB;
constexpr size_t WS_GATES = 496 * MiB;
constexpr size_t WS_KN = 752 * MiB, WS_VM = 816 * MiB, WS_OM = 880 * MiB, WS_OF = 944 * MiB, WS_END = 1018 * MiB;
constexpr size_t WS_U = 432 * MiB;
constexpr int LDS_TOTAL = 131072 + 1024;
static_assert(att::LDS_BYTES <= 131072, "attention LDS");

#define XB_TMO      128
#define XB_XCNT(j)  (256  + 64 * (j))
#define XB_XSUB(j)  (1280 + 64 * (j))
#define XB_XGEN(j)  (2304 + 64 * (j))
#define XB_TOP      3328
#define XB_TOPGEN   3392
#define XCD_BAR_WORDS 3456
#define XB_SPIN_CAP (1u << 18)

__device__ __forceinline__ unsigned xb_ld(unsigned* p)              { return __hip_atomic_load(p, __ATOMIC_RELAXED, __HIP_MEMORY_SCOPE_AGENT); }
__device__ __forceinline__ unsigned xb_add(unsigned* p, unsigned v) { return __hip_atomic_fetch_add(p, v, __ATOMIC_RELAXED, __HIP_MEMORY_SCOPE_AGENT); }
__device__ __forceinline__ unsigned xb_xcc_id() { return (unsigned)__builtin_amdgcn_s_getreg((3 << 11) | 20) & 0xFu; }
#define XB_SPIN(cond, bar) do { unsigned _sp = 0; while (cond) { __builtin_amdgcn_s_sleep(1); \
    if ((++_sp & 255u) == 0u) { if (xb_ld(&(bar)[XB_TMO])) break; if (_sp > XB_SPIN_CAP) { atomicAdd(&(bar)[XB_TMO], 1u); break; } } } } while (0)

struct XcdBarrier {
    unsigned* bar; unsigned x;
    volatile LAS unsigned* st;
};

__device__ __forceinline__ XcdBarrier xcd_barrier_post(unsigned* bar, volatile LAS unsigned* st) {
    XcdBarrier b; b.bar = bar; b.x = xb_xcc_id(); b.st = st;
    if (threadIdx.x == 0) (void)xb_add(&bar[XB_XCNT(b.x)], 1u);
    return b;
}
__device__ __forceinline__ void xcd_barrier_complete(unsigned* bar, unsigned x, unsigned& nloc, unsigned& nx) {
    const unsigned G = gridDim.x * gridDim.y * gridDim.z;
    unsigned sum, cnt, mine, sp = 0u;
    for (;;) {
        sum = 0u; cnt = 0u; mine = 0u;
#pragma unroll
        for (unsigned j = 0; j < 16; ++j) { const unsigned c = xb_ld(&bar[XB_XCNT(j)]); sum += c; cnt += (c > 0u) ? 1u : 0u; mine = (j == x) ? c : mine; }
        if (sum == G) break;
        __builtin_amdgcn_s_sleep(1);
        if ((++sp & 255u) == 0u) { if (xb_ld(&bar[XB_TMO])) break; if (sp > XB_SPIN_CAP) { atomicAdd(&bar[XB_TMO], 1u); break; } }
    }
    nloc = mine > 0u ? mine : 1u; nx = cnt > 0u ? cnt : 1u;
}

__device__ __forceinline__ void xcd_barrier(const XcdBarrier& b) {
    asm volatile("s_waitcnt vmcnt(0)" ::: "memory");
    __syncthreads();
    if (threadIdx.x == 0) {
        unsigned* bar = b.bar;
        __builtin_amdgcn_s_waitcnt(0);
        unsigned nloc = b.st[0], nx = b.st[1];
        if (nloc == 0u) { xcd_barrier_complete(bar, b.x, nloc, nx); b.st[0] = nloc; b.st[1] = nx; }
        const unsigned old = xb_add(&bar[XB_XSUB(b.x)], 1u);
        const unsigned gen = old / nloc;
        if (old + 1u == (gen + 1u) * nloc) {
            __builtin_amdgcn_fence(__ATOMIC_RELEASE, "agent");
            asm volatile("s_waitcnt vmcnt(0)" ::: "memory");
            const unsigned og = xb_add(&bar[XB_TOP], 1u);
            const unsigned tg = og / nx;
            if (og + 1u == (tg + 1u) * nx) xb_add(&bar[XB_TOPGEN], 1u);
            else XB_SPIN(xb_ld(&bar[XB_TOPGEN]) == tg, bar);
            __builtin_amdgcn_fence(__ATOMIC_ACQUIRE, "agent");
            xb_add(&bar[XB_XGEN(b.x)], 1u);
            asm volatile("s_waitcnt vmcnt(0)" ::: "memory");
        } else {
            XB_SPIN(xb_ld(&bar[XB_XGEN(b.x)]) == gen, bar);
            __builtin_amdgcn_fence(__ATOMIC_ACQUIRE, "agent");
            asm volatile("s_waitcnt vmcnt(0)" ::: "memory");
        }
    }
    __syncthreads();
}

constexpr size_t WS_PCNT = 3 * MiB + 512 * 1024;
constexpr size_t WS_BAR = 3 * MiB;

struct Own { int xi, nx, lr, nloc; };
#ifndef BATCH_MAP
#define BATCH_MAP 1
#endif
__device__ __forceinline__ int own_panel(const Own& o, int k) {
    if (BATCH_MAP && o.nx == 8 && MROWS / 256 == 128) { if (k >= 16) return 1 << 20; const int s = o.xi & 1, qb = s ? 8 + k : (k < 8 ? k : 16 + k); return 32 * (o.xi >> 1) + qb; }
    return k * o.nx + ((k & 1) ? o.nx - 1 - o.xi : o.xi); }
__device__ __forceinline__ int own_npan(const Own& o, int nM) { int n = 0; while (own_panel(o, n) < nM) ++n; return n; }
#ifndef XGM
#define XGM 4
#endif
struct XOrder {
    Own o; int nN, npan, nunits;
    __device__ __forceinline__ void init(int M, int N, const Own& o_) { o = o_; if (!OWN_GEMM) { o.nx = 8; o.nloc = gridDim.x / 8; o.xi = blockIdx.x % 8; o.lr = blockIdx.x / 8; } nN = N / 256; npan = own_npan(o, M / 256); nunits = npan * nN; }
    __device__ __forceinline__ bool next(int i, pg8::Unit& u) const {
        const int L = i * o.nloc + o.lr; if (L >= nunits) return false;
        const int nig = XGM * nN, gid = L / nig, fm = gid * XGM, gsz = (npan - fm) < XGM ? (npan - fm) : XGM, r = L - gid * nig;
        u.pm = own_panel(o, fm + r % gsz); u.pn = r / gsz; return true;
    }
    __device__ __forceinline__ void a_ready(const pg8::Unit&) const {}
    __device__ __forceinline__ void done(const pg8::Unit&) const {}
};
#ifndef CUT_MASK
#define CUT_MASK (MK_MULTI ? 0xff : 0)
#endif
struct Args { const float* in[15]; float* out; unsigned char* ws; int ph_lo, ph_hi, li, pad; };

__device__ __forceinline__ unsigned f2bf(float f) { unsigned u = __builtin_bit_cast(unsigned, f); return (u + 0x7fffu + ((u >> 16) & 1u)) >> 16; }
__device__ __forceinline__ unsigned pk2(float lo, float hi) { return f2bf(lo) | (f2bf(hi) << 16); }
__device__ __forceinline__ float wave_sum(float v) {
#pragma unroll
    for (int o = 1; o < 64; o <<= 1) v += __shfl_xor(v, o);
    return v;
}
__device__ __forceinline__ int map_col(int id, int j) {
    if (id == 1) { if (j < 768) return j; if (j < 832) { const int i = j - 768; return 768 + (i < 32 ? 2 * i : 2 * (i - 32) + 1); }
                   if (j < 3904) return 1024 + (j - 832); if (j < 3912) return 832 + (j - 3904); return 4096 + (j - 3912); }
    if (id == 2) { const int h = j / 192, r = j - h * 192; if (r < 128) return j; const int i = r - 128; return 192 * h + 128 + (i < 32 ? 2 * i : 2 * (i - 32) + 1); }
    if (id == 3) { const int h = j >> 8, r = j & 255; return r < 128 ? 128 * h + r : 1024 + 128 * h + (r - 128); }
    return j;
}
__device__ __forceinline__ void p0_transpose_item(const float* W, int K, int N, bf16b* WT, const float* gain, int mapid, LAS float* scr, int item, int lane) {
    const int nblk = (N + 31) / 32, kb = item / nblk, nb = item - kb * nblk, k0 = 64 * kb, n0 = 32 * nb;
    const int col = n0 + (lane & 31);
#pragma unroll 8
    for (int i = 0; i < 32; ++i) { const int kk = 2 * i + (lane >> 5); float v = 0.f; if (col < N) { v = W[(size_t)(k0 + kk) * N + col]; if (gain) v *= gain[k0 + kk]; } scr[kk * 33 + (lane & 31)] = v; }
    asm volatile("s_waitcnt lgkmcnt(0)" ::: "memory");
    const int c = lane & 7;
#pragma unroll
    for (int j = 0; j < 4; ++j) { const int n = (lane >> 3) + 8 * j; const LAS float* s = scr + (8 * c) * 33 + n;
        if (n0 + n < N) { v4u o; o.x = pk2(s[0 * 33], s[1 * 33]); o.y = pk2(s[2 * 33], s[3 * 33]); o.z = pk2(s[4 * 33], s[5 * 33]); o.w = pk2(s[6 * 33], s[7 * 33]);
            *(v4u*)(WT + (size_t)map_col(mapid, n0 + n) * K + k0 + 8 * c) = o; } }
    asm volatile("s_waitcnt lgkmcnt(0)" ::: "memory");
}


struct TDesc { const float* W; const float* gain; bf16b* WT; int K, N, mapid, item; };
__device__ __forceinline__ void p0_item_load(const TDesc& d, int lane, f32x4 (&v)[8], float (&g)[8]) {
    const int nblk = (d.N + 31) / 32, kb = d.item / nblk, nb = d.item - kb * nblk, k0 = 64 * kb, col = 32 * nb + 4 * (lane & 7), kr = lane >> 3;
#pragma unroll
    for (int i = 0; i < 8; ++i) { const int k = k0 + 8 * i + kr; v[i] = (f32x4){0.f, 0.f, 0.f, 0.f}; if (col < d.N) v[i] = *(const f32x4*)(d.W + (size_t)k * d.N + col); g[i] = d.gain ? d.gain[k] : 1.f; }
}
__device__ __forceinline__ void p0_item_store(const TDesc& d, int lane, const f32x4 (&v)[8], const float (&g)[8], LAS float* scr) {
    const int nblk = (d.N + 31) / 32, kb = d.item / nblk, nb = d.item - kb * nblk, k0 = 64 * kb, n0 = 32 * nb, kr = lane >> 3, c4 = lane & 7;
#pragma unroll
    for (int i = 0; i < 8; ++i) { LAS float* s = scr + (8 * i + kr) * 33 + 4 * c4; const f32x4 xv = v[i] * g[i]; s[0] = xv.x; s[1] = xv.y; s[2] = xv.z; s[3] = xv.w; }
    asm volatile("s_waitcnt lgkmcnt(0)" ::: "memory");
    const int c = lane & 7;
#pragma unroll
    for (int j = 0; j < 4; ++j) { const int n = (lane >> 3) + 8 * j; const LAS float* s = scr + (8 * c) * 33 + n;
        if (n0 + n < d.N) { v4u o; o.x = pg8::cvt_pk_bf16(s[0 * 33], s[1 * 33]); o.y = pg8::cvt_pk_bf16(s[2 * 33], s[3 * 33]); o.z = pg8::cvt_pk_bf16(s[4 * 33], s[5 * 33]); o.w = pg8::cvt_pk_bf16(s[6 * 33], s[7 * 33]);
            *(v4u*)(d.WT + (size_t)map_col(d.mapid, n0 + n) * d.K + k0 + 8 * c) = o; } }
    asm volatile("s_waitcnt lgkmcnt(0)" ::: "memory");
}

__global__ void __launch_bounds__(512) fwd_megakernel(Args args) {
    extern __shared__ __attribute__((aligned(16))) unsigned char lds[];
    LAS unsigned char* ldsL = (LAS unsigned char*)lds;
    const int tid = threadIdx.x, lane = tid & 63, wave = __builtin_amdgcn_readfirstlane(tid >> 6);
    const int G = gridDim.x, bx = blockIdx.x;
    const int vcu = (G % 8 == 0) ? (bx % 8) * (G / 8) + bx / 8 : bx;
    unsigned char* ws = args.ws;
    const float* x = args.in[0];
    float* out = args.out;
    float* SQ = (float*)(ws + WS_SQ); float* SKV = (float*)(ws + WS_SKV); float* SH1 = (float*)(ws + WS_SH1); float* SH2 = (float*)(ws + WS_SH2); float* ROPE = (float*)(ws + WS_ROPE);
    bf16b* Win_t = (bf16b*)(ws + WS_WIN); bf16b* Wuq_t = (bf16b*)(ws + WS_WUQ); bf16b* Wukv_t = (bf16b*)(ws + WS_WUKV); bf16b* Wm_t = (bf16b*)(ws + WS_WM);
    bf16b* Wf_t = (bf16b*)(ws + WS_WF); bf16b* Wout_t = (bf16b*)(ws + WS_WOUT); bf16b* Wup_t = (bf16b*)(ws + WS_WUP); bf16b* Wdown_t = (bf16b*)(ws + WS_WDOWN);
    bf16b* XN = (bf16b*)(ws + WS_XN); bf16b* QM = XN; bf16b* MIX = XN;
    bf16b* CQ = (bf16b*)(ws + WS_CQ); bf16b* CKV = (bf16b*)(ws + WS_CKV); bf16b* KR = (bf16b*)(ws + WS_KR); float* FF = (float*)(ws + WS_FF); float* BIASK = (float*)(ws + WS_BIAS);
    bf16b* FQ = (bf16b*)(ws + WS_FQ); bf16b* H1B = FQ; bf16b* GATES = (bf16b*)(ws + WS_GATES);
    bf16b* KN = (bf16b*)(ws + WS_KN); bf16b* VM = (bf16b*)(ws + WS_VM); bf16b* OM = (bf16b*)(ws + WS_OM); bf16b* OF = (bf16b*)(ws + WS_OF); bf16b* U = (bf16b*)(ws + WS_U);
    const int lo = args.ph_lo, hi = args.ph_hi;
    volatile LAS unsigned* bst = (volatile LAS unsigned*)(ldsL + 131072);
    XcdBarrier bar; bar.bar = (unsigned*)(ws + WS_BAR) + args.li * XCD_BAR_WORDS; bar.x = xb_xcc_id(); bar.st = bst;
    if (tid == 0) {
        const unsigned lr_ = xb_add(&bar.bar[XB_XCNT(bar.x)], 1u);
        unsigned sum, cnt, mine, xi_, sp = 0u;
        for (;;) { sum = 0u; cnt = 0u; mine = 0u; xi_ = 0u;
#pragma unroll
            for (unsigned j = 0; j < 16; ++j) { const unsigned c = xb_ld(&bar.bar[XB_XCNT(j)]); sum += c; if (j == bar.x) { mine = c; xi_ = cnt; } cnt += (c > 0u) ? 1u : 0u; }
            if (sum == (unsigned)G) break;
            __builtin_amdgcn_s_sleep(1);
            if (++sp > (1u << 22)) break; }
        bst[0] = mine > 0u ? mine : 1u; bst[1] = cnt > 0u ? cnt : 1u; bst[4] = xi_; bst[5] = lr_;
    }
    __syncthreads();
    Own own; own.nloc = (int)bst[0]; own.nx = (int)bst[1]; own.xi = (int)bst[4]; own.lr = (int)bst[5];
    own.nloc = __builtin_amdgcn_readfirstlane(own.nloc); own.nx = __builtin_amdgcn_readfirstlane(own.nx); own.xi = __builtin_amdgcn_readfirstlane(own.xi); own.lr = __builtin_amdgcn_readfirstlane(own.lr);
    if (args.ph_lo < 0) cg::this_grid().sync();
#ifndef PHMASK
#define PHMASK 0x1ff
#endif
#define IN(k) (((PHMASK >> (k)) & 1) && lo <= (k) && (k) < hi)
#ifndef REPMASK
#define REPMASK 0
#endif
#define REP(k) (((REPMASK >> (k)) & 1) ? 2 : 1)
#define SEAM(k) do { if (IN(k) && IN((k) + 1)) xcd_barrier(bar); } while (0)
    pg8::Epi E{}; E.CQ = CQ; E.CKV = CKV; E.KR = KR; E.FQKV = FQ; E.GATES = GATES; E.QM = QM; E.KN = KN; E.VM = VM; E.MIX = MIX; E.TMP = FQ; E.H1B = H1B; E.U = U;
    E.GN = args.in[14]; E.PCNT = (unsigned*)(ws + WS_PCNT); E.fuse8 = (!MK_MULTI && CUT_MASK == 0 && XGM == 4 && own.nloc == 32) ? 1 : 0;
    E.FF = FF; E.SQ = SQ; E.SKV = SKV; E.SH1 = SH1; E.SH2 = SH2; E.OUT = out; E.X = x; E.ROPE = ROPE;

    if (IN(0)) for (int rp_ = 0; rp_ < REP(0); ++rp_) {
        const int gw = bx * 8 + wave, NGW = G * 8;
        LAS float* scr = (LAS float*)(ldsL + wave * 16384);
        constexpr int I_IN = 32 * 251, I_UQ = 8 * 48, I_UKV = 4 * 64, I_BR = 16 * 64, I_OUT = 32 * 64, I_UP = 32 * 256, I_DN = 128 * 64;
        constexpr int NITEMS = I_IN + I_UQ + I_UKV + 2 * I_BR + I_OUT + I_UP + I_DN;
#define P0_DECODE(D, it_) do { int r = (it_); \
            if (r < I_IN) { (D) = TDesc{args.in[2], args.in[1], Win_t, 2048, DIN, 1, r}; } else { r -= I_IN; \
            if (r < I_UQ) { (D) = TDesc{args.in[5], args.in[4], Wuq_t, 512, 1536, 2, r}; } else { r -= I_UQ; \
            if (r < I_UKV) { (D) = TDesc{args.in[7], args.in[6], Wukv_t, 256, 2048, 3, r}; } else { r -= I_UKV; \
            if (r < I_BR) { (D) = TDesc{args.in[8], nullptr, Wm_t, 1024, 2048, 0, r}; } else { r -= I_BR; \
            if (r < I_BR) { (D) = TDesc{args.in[9], nullptr, Wf_t, 1024, 2048, 0, r}; } else { r -= I_BR; \
            if (r < I_OUT) { (D) = TDesc{args.in[10], nullptr, Wout_t, 2048, 2048, 0, r}; } else { r -= I_OUT; \
            if (r < I_UP) { (D) = TDesc{args.in[12], args.in[11], Wup_t, 2048, 8192, 0, r}; } else { r -= I_UP; \
            (D) = TDesc{args.in[13], nullptr, Wdown_t, 8192, 2048, 0, r}; } } } } } } } } while (0)
        if (gw < NITEMS) {
            int it = gw; TDesc dc; P0_DECODE(dc, it); f32x4 vc[8]; float gc[8]; p0_item_load(dc, lane, vc, gc);
            for (;;) { const int itn = it + NGW; const bool has = itn < NITEMS; TDesc dn = dc; f32x4 vn[8]; float gn[8];
                if (has) { P0_DECODE(dn, itn); p0_item_load(dn, lane, vn, gn); }
                p0_item_store(dc, lane, vc, gc, scr);
                if (!has) break;
#pragma unroll
                for (int i = 0; i < 8; ++i) { vc[i] = vn[i]; gc[i] = gn[i]; }
                dc = dn; it = itn; }
        }
#undef P0_DECODE
        Own ownr = own; if (!OWN_ROWS) { ownr.nx = 8; ownr.nloc = G / 8; ownr.xi = bx % 8; ownr.lr = bx / 8; }
        const int npan0 = own_npan(ownr, MROWS / 256), xend = npan0 * 256, xstep = ownr.nloc * 8;
        { int idx = ownr.lr * 8 + wave;
          if (idx < xend) { f32x4 v[8]; int m = own_panel(ownr, idx >> 8) * 256 + (idx & 255);
#pragma unroll
            for (int j = 0; j < 8; ++j) v[j] = ((const f32x4*)(x + (size_t)m * DMODEL) + lane)[64 * j];
            for (;;) { const int idn = idx + xstep; const bool has = idn < xend; f32x4 w[8]; int mn = m;
                if (has) { mn = own_panel(ownr, idn >> 8) * 256 + (idn & 255);
#pragma unroll
                    for (int j = 0; j < 8; ++j) w[j] = ((const f32x4*)(x + (size_t)mn * DMODEL) + lane)[64 * j]; }
                float s = 0.f;
#pragma unroll
                for (int j = 0; j < 8; ++j) s += (v[j].x * v[j].x + v[j].y * v[j].y) + (v[j].z * v[j].z + v[j].w * v[j].w);
                const float rs = rsqrtf(wave_sum(s) * (1.f / DMODEL) + EPS);
                unsigned long long* o8 = (unsigned long long*)(XN + (size_t)m * DMODEL) + lane;
#pragma unroll
                for (int j = 0; j < 8; ++j) o8[64 * j] = (unsigned long long)pg8::cvt_pk_bf16(v[j].x * rs, v[j].y * rs) | ((unsigned long long)pg8::cvt_pk_bf16(v[j].z * rs, v[j].w * rs) << 32);
                if (!has) break;
#pragma unroll
                for (int j = 0; j < 8; ++j) v[j] = w[j];
                idx = idn; m = mn; } } }
        const int gt = bx * 512 + tid, NGT = G * 512;
        for (int i = gt; i < SEQ * 32; i += NGT) { const int pos = i >> 5, k = i & 31;
            const float inv = 1.0f / powf(10000.0f, (float)k * (1.0f / 32.0f)); const float ang = (float)pos * inv;
            const double rev = (double)ang * 0.15915494309189535; const float fr = (float)(rev - __builtin_rint(rev));
            ROPE[2 * i] = __builtin_amdgcn_cosf(fr); ROPE[2 * i + 1] = __builtin_amdgcn_sinf(fr); }
    }
    SEAM(0);
    if (IN(1)) for (int rp_ = 0; rp_ < REP(1); ++rp_) { pg8::Gemm g{XN, Win_t, MROWS, NPROJ, 2048}; XOrder S; S.init(MROWS, NPROJ, own); E.mode = EM_PROJ;
        pg8::gemm_phase<pg8::Epi, XOrder, true, true>(ldsL, g, S, E); }
    SEAM(1);
    if (IN(2)) for (int rp_ = 0; rp_ < REP(2); ++rp_) {
        if (bx < 32) {
            const int b = bx >> 3, h = bx & 7; const float fb = args.in[3][h]; float v[16]; float run = 0.f;
#pragma unroll
            for (int i = 0; i < 16; ++i) { const float z = FF[((size_t)b * SEQ + tid * 16 + i) * 8 + h] + fb; const float ls = fminf(z, 0.f) - log1pf(expf(-fabsf(z))); run += ls; v[i] = run; }
            float incl = run;
#pragma unroll
            for (int o = 1; o < 64; o <<= 1) { const float t = __shfl_up(incl, o); if (lane >= o) incl += t; }
            LAS float* wt = (LAS float*)ldsL;
            if (lane == 63) wt[wave] = incl;
            __syncthreads();
            float base = incl - run;
            for (int w = 0; w < wave; ++w) base += wt[w];
            float* dst = BIASK + ((size_t)bx * SEQ + tid * 16);
#pragma unroll
            for (int i = 0; i < 16; ++i) dst[i] = -(base + v[i]) * 11.313708498984761f;
            __syncthreads();
        }
        { pg8::Gemm g{CQ, Wuq_t, MROWS, 1536, 512}; XOrder S; S.init(MROWS, 1536, own); E.mode = EM_QUP;
          pg8::gemm_phase<pg8::Epi, XOrder, true, true>(ldsL, g, S, E); }
        { pg8::Gemm g{CKV, Wukv_t, MROWS, 2048, 256}; XOrder S; S.init(MROWS, 2048, own); E.mode = EM_KVUP;
          pg8::gemm_phase<pg8::Epi, XOrder, true, true>(ldsL, g, S, E); }
    }
    SEAM(2);
    if (IN(3)) {
        using att::bf16; using att::BlockRef;
        Own owna = own; if (!OWN_ATT) { owna.nx = 8; owna.nloc = G / 8; owna.xi = bx % 8; owna.lr = bx / 8; }
        const int npanA = own_npan(owna, MROWS / 256); const bool fastdeal = (owna.nx == 8 && owna.nloc == 32 && npanA == 16);
#define MKREF(R, MODE_, e_) do { int pm_, h_; if (fastdeal && BATCH_MAP) { const int i_ = (e_) >> 6, which_ = ((e_) >> 5) & 1, l_ = (e_) & 31, p_ = l_ & 7, s_ = owna.xi & 1; h_ = 4 * i_ + (l_ >> 3); \
                pm_ = 32 * (owna.xi >> 1) + (which_ == 0 ? (s_ ? 23 - p_ : 31 - p_) : (s_ ? 8 + p_ : p_)); }     \
            else if (fastdeal) { const int j_ = (e_) & 31, i_ = (e_) >> 5; pm_ = own_panel(owna, (j_ >> 3) * 4 + i_); h_ = j_ & 7; } else { pm_ = own_panel(owna, (e_) >> 3); h_ = (e_) & 7; } \
            const int b_ = pm_ >> 5, qb_ = pm_ & 31, grp_ = b_ * 8 + h_; const size_t rb_ = (size_t)b_ * SEQ, rq_ = rb_ + (size_t)qb_ * 256; (R).P0 = qb_ * 256; \
            if ((MODE_) == 0) { (R).Q = (const bf16*)FQ + rq_ * 1024 + h_ * 128; (R).K = (const bf16*)FQ + (size_t)MROWS * 1024 + rb_ * 1024 + h_ * 128; (R).V = (const bf16*)FQ + (size_t)MROWS * 2048 + rb_ * 1024 + h_ * 128; \
                (R).O = (bf16*)OF + rq_ * 1024 + h_ * 128; (R).KR = nullptr; (R).BIAS = BIASK + (size_t)grp_ * SEQ; } \
            else { (R).Q = (const bf16*)QM + rq_ * 1536 + h_ * 192; (R).K = (const bf16*)KN + rb_ * 1024 + h_ * 128; (R).V = (const bf16*)VM + rb_ * 1024 + h_ * 128; \
                (R).O = (bf16*)OM + rq_ * 1024 + h_ * 128; (R).KR = (const bf16*)KR + rb_ * 64; (R).BIAS = nullptr; } } while (0)
#define STREAM(MODE_) do { for (int e = owna.lr; e < npanA * 8; e += owna.nloc) { BlockRef cur; MKREF(cur, MODE_, e); att::attn_block_np<MODE_>(cur, (char*)lds); } } while (0)
#if ATT_PIPE_FOX || ATT_PIPE_MLA
#define STREAMP(MODE_) do { int e = owna.lr; if (e < npanA * 8) { BlockRef cur, nxt; MKREF(cur, MODE_, e); att::Seam<MODE_> S; att::attn_prime<MODE_>(cur, (char*)lds, S); \
            for (;;) { const int en = e + owna.nloc; const bool last = en >= npanA * 8; if (last) nxt = cur; else MKREF(nxt, MODE_, en); \
                att::attn_block<MODE_>(cur, nxt, (char*)lds, S); if (last) break; cur = nxt; e = en; } } } while (0)
#endif
#ifndef ATT_REPEAT
#define ATT_REPEAT 1
#endif
        for (int rep = 0; rep < ATT_REPEAT; ++rep) {
#ifndef NO_FOX
#if ATT_PIPE_FOX
        STREAMP(0);
#else
        STREAM(0);
#endif
#endif
#ifndef NO_MLA
#if ATT_PIPE_MLA
        STREAMP(1);
#else
        STREAM(1);
#endif
#endif
        }
#undef STREAM
#undef MKREF
    }
    SEAM(3);
    if (IN(4)) for (int rp_ = 0; rp_ < REP(4); ++rp_) {
        { pg8::Gemm g{OM, Wm_t, MROWS, 2048, 1024}; XOrder S; S.init(MROWS, 2048, own); E.mode = EM_BR1;
          pg8::gemm_phase<pg8::Epi, XOrder, true, true>(ldsL, g, S, E); }
        { pg8::Gemm g{OF, Wf_t, MROWS, 2048, 1024}; XOrder S; S.init(MROWS, 2048, own); E.mode = EM_BR2;
          pg8::gemm_phase<pg8::Epi, XOrder, true, true>(ldsL, g, S, E); }
    }
    SEAM(4);
    if (IN(5)) for (int rp_ = 0; rp_ < REP(5); ++rp_) { pg8::Gemm g{MIX, Wout_t, MROWS, 2048, 2048}; XOrder S; S.init(MROWS, 2048, own); E.mode = EM_OUT;
        pg8::gemm_phase<pg8::Epi, XOrder, true, true>(ldsL, g, S, E); }
    SEAM(5);
    if (IN(6)) for (int rp_ = 0; rp_ < REP(6); ++rp_) { pg8::Gemm g{H1B, Wup_t, MROWS, DFF, 2048}; XOrder S; S.init(MROWS, DFF, own); E.mode = EM_UP;
        pg8::gemm_phase<pg8::Epi, XOrder, true, true>(ldsL, g, S, E); }
    SEAM(6);
    if (IN(7)) { pg8::Gemm g{U, Wdown_t, MROWS, 2048, DFF}; XOrder S; S.init(MROWS, 2048, own); E.mode = EM_DOWN;
        pg8::gemm_phase<pg8::Epi, XOrder, true, true>(ldsL, g, S, E); }
    SEAM(7);
    if (IN(8) && !E.fuse8) {
        const float* gn = args.in[14]; Own ownr = own; if (!OWN_ROWS) { ownr.nx = 8; ownr.nloc = G / 8; ownr.xi = bx % 8; ownr.lr = bx / 8; } const int npan8 = own_npan(ownr, MROWS / 256);
        f32x4 gv[8];
#pragma unroll
        for (int j = 0; j < 8; ++j) gv[j] = ((const f32x4*)gn)[lane + 64 * j];
        for (int idx = ownr.lr * 8 + wave; idx < npan8 * 256; idx += ownr.nloc * 8) { const int m = own_panel(ownr, idx >> 8) * 256 + (idx & 255); f32x4* orow = (f32x4*)(out + (size_t)m * DMODEL) + lane; const int r_ = m & 255; float sq = lane < 32 ? SH2[((((size_t)(m >> 8) * 32 + lane) * 2 + ((r_ >> 6) & 1)) * 16 + (r_ & 15)) * 8 + (r_ >> 7) * 4 + ((r_ >> 4) & 3)] : 0.f; sq = wave_sum(sq); const float rs = rsqrtf(sq * (1.f / DMODEL) + EPS);
#pragma unroll
            for (int j = 0; j < 8; ++j) { f32x4 v = orow[64 * j]; orow[64 * j] = v * rs * gv[j]; } }
    }
#undef IN
#undef SEAM
}

extern "C" void kernel_launch(void* const* d_in, const int* in_sizes, int n_in, void* d_out, int out_size, void* d_ws, size_t ws_size, hipStream_t stream) {
    static int grid = 0;
    if (grid == 0) {
        if (n_in != 15 || in_sizes[0] != MROWS * DMODEL || out_size != MROWS * DMODEL || ws_size < WS_END) {
            fprintf(stderr, "kernel_launch: unexpected shapes (n_in %d, in0 %d, out %d, ws %zu < %zu)\n", n_in, n_in > 0 ? in_sizes[0] : -1, out_size, ws_size, (size_t)WS_END); grid = -1; return; }
        int dev = 0, cus = 0, per_cu = 0;
        (void)hipGetDevice(&dev); (void)hipDeviceGetAttribute(&cus, hipDeviceAttributeMultiprocessorCount, dev);
        if (hipFuncSetAttribute((const void*)fwd_megakernel, hipFuncAttributeMaxDynamicSharedMemorySize, LDS_TOTAL) != hipSuccess) { fprintf(stderr, "kernel_launch: hipFuncSetAttribute failed\n"); grid = -1; return; }
        if (hipOccupancyMaxActiveBlocksPerMultiprocessor(&per_cu, (const void*)fwd_megakernel, 512, LDS_TOTAL) != hipSuccess || per_cu < 1) { fprintf(stderr, "kernel_launch: occupancy query says %d\n", per_cu); per_cu = 1; }
        (void)hipGetLastError();
        if (cus <= 0) cus = 256;
        grid = cus;
    }
    if (grid < 0) return;
    Args a{};
    for (int i = 0; i < 15; ++i) a.in[i] = (const float*)d_in[i];
    a.out = (float*)d_out; a.ws = (unsigned char*)d_ws;
    (void)hipMemsetAsync((unsigned char*)d_ws + WS_BAR, 0, 512 * 1024 + 128 * 256, stream);
    int li = 0;
    for (int p = 0; p < 9; ) { int q = p; while (q < 8 && !((CUT_MASK >> q) & 1)) ++q;
        a.ph_lo = p; a.ph_hi = q + 1; a.li = li++;
        void* kargs[] = {&a};
        hipError_t e = hipLaunchCooperativeKernel((const void*)fwd_megakernel, dim3(grid), dim3(512), kargs, LDS_TOTAL, stream);
        if (e != hipSuccess) fprintf(stderr, "kernel_launch: cooperative launch failed: %s (grid %d)\n", hipGetErrorString(e), grid);
        p = q + 1; }
}
```
